# Optimizing an MI355X kernel written in HIP

```python
import math
import jax
import jax.numpy as jnp
from jax import lax
import numpy as np

D_MODEL = 2048
BATCH = 2
SEQ = 4096
DEPTH = 4

SSM_GROUPS = 32
SSM_CH = 16
SSM_STATE = 64
SSM_WIDTH = SSM_GROUPS * SSM_CH
SSM_DT_MIN = 1e-3
SSM_DT_MAX = 1e-1
DN_HEADS = 6
DN_HEAD_DIM = 128
DN_WIDTH = DN_HEADS * DN_HEAD_DIM
DN_CONV = 4
DN_CHUNK = 64
ATTN_HEADS = 6
ATTN_HEAD_DIM = 128
ATTN_WIDTH = ATTN_HEADS * ATTN_HEAD_DIM
DILATED_PAIRS = ((128, 1), (512, 4), (2048, 16))
ATTN_BLOCK = 128
N_BUCKETS = 32
REL_MAX_DIST = 2048
D_MIX = SSM_WIDTH + DN_WIDTH + ATTN_WIDTH
IN_SPLITS = (SSM_WIDTH, ATTN_WIDTH, ATTN_WIDTH, ATTN_WIDTH, 3 * DN_WIDTH, DN_WIDTH, DN_HEADS, DN_HEADS)
N_IN_COLS = SSM_WIDTH + 3 * ATTN_WIDTH + 4 * DN_WIDTH + 2 * DN_HEADS
D_FF = 5632
NORM_EPS = 1e-6
NEG_INF = -1e30

kernel_name = 'hybrid_s5_gdn_dilated_macaron'


def rms_norm(x, gain):
    xf = x.astype(jnp.float32)
    y = xf * lax.rsqrt(jnp.mean(xf * xf, axis=-1, keepdims=True) + NORM_EPS)
    return (y * gain.astype(jnp.float32)).astype(x.dtype)


def l2_normalize(x):
    return x * lax.rsqrt(jnp.sum(x * x, axis=-1, keepdims=True) + NORM_EPS)


def swiglu(h, w_gate, w_up, w_down):
    return (jax.nn.silu(h @ w_gate) * (h @ w_up)) @ w_down


def causal_depthwise_conv(x, w):
    k_width, channels = w.shape
    return lax.conv_general_dilated(x, w[:, None, :], window_strides=(1,), padding=((k_width - 1, 0),),
                                    dimension_numbers=('NWC', 'WIO', 'NWC'), feature_group_count=channels)


def s5_layer(u, lam_re, lam_im, b_re, b_im, c_re, c_im, d_skip, log_dt, glu_w, glu_b):
    bsz, seq, _ = u.shape
    f32 = jnp.float32
    uf = u.astype(f32).reshape(bsz, seq, SSM_GROUPS, SSM_CH)
    lam = lax.complex(lam_re.astype(f32), lam_im.astype(f32))
    dt = jnp.exp(log_dt.astype(f32))[:, None]
    lam_bar = jnp.exp(lam * dt)
    b = lax.complex(b_re.astype(f32), b_im.astype(f32))
    b_bar = ((lam_bar - 1.0) / lam)[..., None] * b
    c = lax.complex(c_re.astype(f32), c_im.astype(f32))
    bu = jnp.einsum('gpc,bsgc->bsgp', b_bar, uf.astype(jnp.complex64))
    a = jnp.broadcast_to(lam_bar, bu.shape)

    def combine(e1, e2):
        a1, b1 = e1
        a2, b2 = e2
        return a1 * a2, a2 * b1 + b2

    _, states = lax.associative_scan(combine, (a, bu), axis=1)
    y = jnp.einsum('gcp,bsgp->bsgc', c, states).real + d_skip.astype(f32).reshape(SSM_GROUPS, SSM_CH) * uf
    y = jax.nn.gelu(y.reshape(bsz, seq, SSM_WIDTH))
    return y * jax.nn.sigmoid(y @ glu_w.astype(f32) + glu_b.astype(f32))


def to_chunks(t, chunk):
    bsz, seq, heads = t.shape[:3]
    t = t.reshape(bsz, seq // chunk, chunk, heads, *t.shape[3:])
    return jnp.moveaxis(t, 3, 1)


def gated_delta_rule(q, k, v, g, beta):
    bsz, seq, heads, dk = q.shape
    dv = v.shape[-1]
    q = to_chunks(q * dk ** -0.5, DN_CHUNK)
    k, v = to_chunks(k, DN_CHUNK), to_chunks(v, DN_CHUNK)
    g, beta = to_chunks(g, DN_CHUNK), to_chunks(beta, DN_CHUNK)
    gc = jnp.cumsum(g, axis=-1)
    idx = jnp.arange(DN_CHUNK)
    causal = idx[:, None] >= idx[None, :]
    strict = idx[:, None] > idx[None, :]
    decay = jnp.exp(jnp.where(causal, gc[..., :, None] - gc[..., None, :], NEG_INF))
    k_beta = k * beta[..., None]
    a_mat = jnp.where(strict, jnp.einsum('bhnck,bhnek->bhnce', k_beta, k) * decay, 0.0)
    eye = jnp.eye(DN_CHUNK, dtype=jnp.float32)
    t_inv = lax.linalg.triangular_solve(eye + a_mat, jnp.broadcast_to(eye, a_mat.shape),
                                        left_side=True, lower=True, unit_diagonal=True)
    u = jnp.einsum('bhnce,bhnev->bhncv', t_inv, v * beta[..., None])
    w = jnp.einsum('bhnce,bhnek->bhnck', t_inv, k_beta * jnp.exp(gc)[..., None])
    attn = jnp.einsum('bhnck,bhnek->bhnce', q, k) * decay
    q_dec = q * jnp.exp(gc)[..., None]
    k_tail = k * jnp.exp(gc[..., -1:] - gc)[..., None]
    chunk_decay = jnp.exp(gc[..., -1])
    xs = tuple(jnp.moveaxis(t, 2, 0) for t in (q_dec, k_tail, u, w, attn, chunk_decay))

    def step(state, inp):
        qd, kt, un, wn, an, dec = inp
        v_new = un - jnp.einsum('bhck,bhkv->bhcv', wn, state)
        o = jnp.einsum('bhck,bhkv->bhcv', qd, state) + jnp.einsum('bhce,bhev->bhcv', an, v_new)
        state = state * dec[..., None, None] + jnp.einsum('bhck,bhcv->bhkv', kt, v_new)
        return state, o

    state0 = jnp.zeros((bsz, heads, dk, dv), jnp.float32)
    _, o = lax.scan(step, state0, xs)
    o = jnp.moveaxis(o, 0, 2).reshape(bsz, heads, seq, dv)
    return jnp.swapaxes(o, 1, 2)


def t5_bucket(dist):
    max_exact = N_BUCKETS // 2
    d = jnp.maximum(dist, 1).astype(jnp.float32)
    large = max_exact + jnp.log(d / max_exact) / math.log(REL_MAX_DIST / max_exact) * (N_BUCKETS - max_exact)
    large = jnp.minimum(large.astype(jnp.int32), N_BUCKETS - 1)
    return jnp.where(dist < max_exact, dist, large)


def dilated_branch(q, k, v, rel_bias, window, dil):
    bsz, seq, heads, dh = q.shape
    blk = ATTN_BLOCK
    sub_len = seq // dil
    n_blocks = -(-sub_len // blk)
    sub_pad = n_blocks * blk

    def to_sub(t):
        t = t.astype(jnp.float32).reshape(bsz, sub_len, dil, heads, dh).transpose(0, 2, 1, 3, 4)
        return jnp.pad(t, ((0, 0), (0, 0), (0, sub_pad - sub_len), (0, 0), (0, 0)))

    def band(t):
        tp = jnp.pad(t, ((0, 0), (0, 0), (blk, 0), (0, 0), (0, 0)))
        prev = tp[:, :, :sub_pad].reshape(bsz, dil, n_blocks, blk, heads, dh)
        cur = tp[:, :, blk:].reshape(bsz, dil, n_blocks, blk, heads, dh)
        return jnp.concatenate([prev, cur], axis=3)

    qb = to_sub(q).reshape(bsz, dil, n_blocks, blk, heads, dh) * dh ** -0.5
    kb = band(to_sub(k))
    vb = band(to_sub(v))
    rel = blk + jnp.arange(blk)[:, None] - jnp.arange(2 * blk)[None, :]
    key_idx = jnp.arange(n_blocks)[:, None] * blk + jnp.arange(2 * blk)[None, :] - blk
    valid = ((rel >= 0) & (rel <= window // dil))[None] & (key_idx >= 0)[:, None, :]
    bias = jnp.moveaxis(rel_bias.astype(jnp.float32)[t5_bucket(jnp.maximum(rel, 0) * dil)], -1, 0)
    logits = jnp.einsum('bgnqhd,bgnkhd->bhgnqk', qb, kb) + bias[None, :, None, None]
    logits = jnp.where(valid[None, None, None], logits, NEG_INF)
    m = jnp.max(logits, axis=-1, keepdims=True)
    p = jnp.exp(logits - m)
    s = jnp.sum(p, axis=-1, keepdims=True)
    o = jnp.einsum('bhgnqk,bgnkhd->bgnqhd', p / s, vb)
    lse = (m + jnp.log(s))[..., 0].reshape(bsz, heads, dil, sub_pad)[..., :sub_len]
    o = o.reshape(bsz, dil, sub_pad, heads, dh)[:, :, :sub_len].transpose(0, 2, 1, 3, 4).reshape(bsz, seq, heads, dh)
    lse = lse.transpose(0, 3, 2, 1).reshape(bsz, seq, heads)
    return o, lse


def dilated_attention(q, k, v, rel_bias):
    outs, lses = [], []
    for window, dil in DILATED_PAIRS:
        o, lse = dilated_branch(q, k, v, rel_bias, window, dil)
        outs.append(o)
        lses.append(lse)
    weights = jax.nn.softmax(jnp.stack(lses, axis=0), axis=0)
    return jnp.einsum('gbsh,gbshd->bshd', weights, jnp.stack(outs, axis=0))


def hybrid_mixer(h, w_in, w_out, ssm_lambda_re, ssm_lambda_im, ssm_b_re, ssm_b_im, ssm_c_re, ssm_c_im,
                 ssm_d, ssm_log_dt, ssm_glu_w, ssm_glu_b, ssm_out_gain, dn_conv_w, dn_a_log, dn_dt_bias,
                 dn_norm_gain, attn_out_gain, rel_bias):
    bsz, seq, _ = h.shape
    f32 = jnp.float32
    proj = h @ w_in
    cuts = [sum(IN_SPLITS[:i + 1]) for i in range(len(IN_SPLITS) - 1)]
    u_ssm, a_q, a_k, a_v, dn_qkv, dn_z, dn_a, dn_b = jnp.split(proj, cuts, axis=-1)

    y_ssm = rms_norm(s5_layer(u_ssm, ssm_lambda_re, ssm_lambda_im, ssm_b_re, ssm_b_im, ssm_c_re, ssm_c_im,
                              ssm_d, ssm_log_dt, ssm_glu_w, ssm_glu_b), ssm_out_gain)

    qkv = jax.nn.silu(causal_depthwise_conv(dn_qkv, dn_conv_w)).astype(f32)
    d_q, d_k, d_v = [t.reshape(bsz, seq, DN_HEADS, DN_HEAD_DIM) for t in jnp.split(qkv, 3, axis=-1)]
    d_q, d_k = l2_normalize(d_q), l2_normalize(d_k)
    beta = jax.nn.sigmoid(dn_b.astype(f32))
    g = -jnp.exp(dn_a_log.astype(f32)) * jax.nn.softplus(dn_a.astype(f32) + dn_dt_bias.astype(f32))
    o_dn = gated_delta_rule(d_q, d_k, d_v, g, beta)
    o_dn = rms_norm(o_dn, dn_norm_gain) * jax.nn.silu(dn_z.astype(f32).reshape(bsz, seq, DN_HEADS, DN_HEAD_DIM))
    y_dn = o_dn.reshape(bsz, seq, DN_WIDTH)

    at_q, at_k, at_v = [t.reshape(bsz, seq, ATTN_HEADS, ATTN_HEAD_DIM) for t in (a_q, a_k, a_v)]
    o_at = dilated_attention(at_q, at_k, at_v, rel_bias).reshape(bsz, seq, ATTN_WIDTH)
    y_at = rms_norm(o_at, attn_out_gain)

    mix = jnp.concatenate([y_ssm.astype(h.dtype), y_dn.astype(h.dtype), y_at.astype(h.dtype)], axis=-1)
    return mix @ w_out


def setup_inputs(seed: int = 0) -> dict:
    key = jax.random.key(seed)
    ks = jax.random.split(key, 24)
    f32 = jnp.float32

    def nrm(k, shape, scale):
        return scale * jax.random.normal(k, shape, f32)

    x = jax.random.normal(ks[0], (BATCH, SEQ, D_MODEL), f32)
    norm_gains = 1.0 + nrm(ks[1], (DEPTH, 6, D_MODEL), 0.05)
    ffn_w_gate = nrm(ks[2], (DEPTH, 2, D_MODEL, D_FF), D_MODEL ** -0.5)
    ffn_w_up = nrm(ks[3], (DEPTH, 2, D_MODEL, D_FF), D_MODEL ** -0.5)
    ffn_w_down = nrm(ks[4], (DEPTH, 2, D_FF, D_MODEL), D_FF ** -0.5)
    w_in = nrm(ks[5], (DEPTH, D_MODEL, N_IN_COLS), D_MODEL ** -0.5)
    w_out = nrm(ks[6], (DEPTH, D_MIX, D_MODEL), D_MIX ** -0.5)
    n_idx = jnp.arange(SSM_STATE, dtype=f32)
    ssm_lambda_re = -0.5 + nrm(ks[7], (DEPTH, SSM_GROUPS, SSM_STATE), 0.01)
    ssm_lambda_im = math.pi * n_idx + nrm(ks[8], (DEPTH, SSM_GROUPS, SSM_STATE), 0.01)
    ssm_b_re = nrm(ks[9], (DEPTH, SSM_GROUPS, SSM_STATE, SSM_CH), (2 * SSM_CH) ** -0.5)
    ssm_b_im = nrm(ks[10], (DEPTH, SSM_GROUPS, SSM_STATE, SSM_CH), (2 * SSM_CH) ** -0.5)
    ssm_c_re = nrm(ks[11], (DEPTH, SSM_GROUPS, SSM_CH, SSM_STATE), (2 * SSM_STATE) ** -0.5)
    ssm_c_im = nrm(ks[12], (DEPTH, SSM_GROUPS, SSM_CH, SSM_STATE), (2 * SSM_STATE) ** -0.5)
    ssm_d = nrm(ks[13], (DEPTH, SSM_WIDTH), 1.0)
    ssm_log_dt = jax.random.uniform(ks[14], (DEPTH, SSM_GROUPS), f32, math.log(SSM_DT_MIN), math.log(SSM_DT_MAX))
    ssm_glu_w = nrm(ks[15], (DEPTH, SSM_WIDTH, SSM_WIDTH), SSM_WIDTH ** -0.5)
    ssm_glu_b = nrm(ks[16], (DEPTH, SSM_WIDTH), 0.02)
    ssm_out_gain = 1.0 + nrm(ks[17], (DEPTH, SSM_WIDTH), 0.05)
    dn_conv_w = nrm(ks[18], (DEPTH, DN_CONV, 3 * DN_WIDTH), DN_CONV ** -0.5)
    dn_a_log = jnp.log(jax.random.uniform(ks[19], (DEPTH, DN_HEADS), f32, 1.0, 16.0))
    dt = jnp.exp(jax.random.uniform(ks[20], (DEPTH, DN_HEADS), f32, math.log(1e-3), math.log(1e-1)))
    dn_dt_bias = dt + jnp.log(-jnp.expm1(-dt))
    dn_norm_gain = 1.0 + nrm(ks[21], (DEPTH, DN_HEAD_DIM), 0.05)
    attn_out_gain = 1.0 + nrm(ks[22], (DEPTH, ATTN_WIDTH), 0.05)
    rel_bias = nrm(ks[23], (N_BUCKETS, ATTN_HEADS), 0.5)
    return {'x': x, 'norm_gains': norm_gains, 'ffn_w_gate': ffn_w_gate, 'ffn_w_up': ffn_w_up,
            'ffn_w_down': ffn_w_down, 'w_in': w_in, 'w_out': w_out,
            'ssm_lambda_re': ssm_lambda_re, 'ssm_lambda_im': ssm_lambda_im,
            'ssm_b_re': ssm_b_re, 'ssm_b_im': ssm_b_im, 'ssm_c_re': ssm_c_re, 'ssm_c_im': ssm_c_im,
            'ssm_d': ssm_d, 'ssm_log_dt': ssm_log_dt, 'ssm_glu_w': ssm_glu_w, 'ssm_glu_b': ssm_glu_b,
            'ssm_out_gain': ssm_out_gain, 'dn_conv_w': dn_conv_w, 'dn_a_log': dn_a_log,
            'dn_dt_bias': dn_dt_bias, 'dn_norm_gain': dn_norm_gain, 'attn_out_gain': attn_out_gain,
            'rel_bias': rel_bias}


def reference(x, norm_gains, ffn_w_gate, ffn_w_up, ffn_w_down, w_in, w_out,
              ssm_lambda_re, ssm_lambda_im, ssm_b_re, ssm_b_im, ssm_c_re, ssm_c_im,
              ssm_d, ssm_log_dt, ssm_glu_w, ssm_glu_b, ssm_out_gain, dn_conv_w, dn_a_log,
              dn_dt_bias, dn_norm_gain, attn_out_gain, rel_bias):
    for l in range(DEPTH):
        gains = norm_gains[l]
        h = rms_norm(x, gains[0])
        x = x + 0.5 * rms_norm(swiglu(h, ffn_w_gate[l, 0], ffn_w_up[l, 0], ffn_w_down[l, 0]), gains[1])
        h = rms_norm(x, gains[2])
        mix = hybrid_mixer(h, w_in[l], w_out[l], ssm_lambda_re[l], ssm_lambda_im[l], ssm_b_re[l], ssm_b_im[l],
                           ssm_c_re[l], ssm_c_im[l], ssm_d[l], ssm_log_dt[l], ssm_glu_w[l], ssm_glu_b[l],
                           ssm_out_gain[l], dn_conv_w[l], dn_a_log[l], dn_dt_bias[l], dn_norm_gain[l],
                           attn_out_gain[l], rel_bias)
        x = x + rms_norm(mix, gains[3])
        h = rms_norm(x, gains[4])
        x = x + 0.5 * rms_norm(swiglu(h, ffn_w_gate[l, 1], ffn_w_up[l, 1], ffn_w_down[l, 1]), gains[5])
    return x
```

```cpp
#include <hip/hip_runtime.h>
#include <cstdio>
#include <cstdint>
namespace pg8 {
#define PG8_LAS __attribute__((address_space(3)))
typedef unsigned short bf16_t;
typedef short bf16x8 __attribute__((ext_vector_type(8)));
typedef float f32x4 __attribute__((ext_vector_type(4)));
typedef unsigned u32x4 __attribute__((ext_vector_type(4)));
constexpr int BM = 256, BK = 64, HALF = 128, HTB = HALF * BK * 2  , STAGE_BYTES = 8 * HTB, NXCD = 8, WGM = 8;

__host__ __device__ __forceinline__ int lds_byte(int r, int c) { const int st = (r >> 4) * 2 + (c >> 5), rr = r & 15, cc = c & 31, ob = rr * 64 + cc * 2; return st * 1024 + (ob ^ (((ob >> 9) & 1) << 5)); }
__host__ __device__ __forceinline__ void stage_rc(int b, int& R, int& C) { const int st = b / 1024, sb = b % 1024, swz = sb ^ (((sb >> 9) & 1) << 5); R = (st >> 1) * 16 + swz / 64; C = (st & 1) * 32 + (swz % 64) / 2; }
__host__ __device__ __forceinline__ int perm32(int rho) { const int n = rho >> 4, i = rho & 15; return 8 * (i >> 2) + 4 * n + (i & 3); }

struct Unit { int pm, pn; };
struct Gemm { const bf16_t* A; const bf16_t* Bt; int M, N, K; };

struct StaticOrder {
    int nM, nN, nwg, G, c;
    __host__ __device__ void init(int M, int N, int G_, int c_) { nM = M / BM; nN = N / BM; nwg = nM * nN; G = G_; c = c_; }
    __host__ __device__ bool next(int i, Unit& u) const {
        const long L = (long)i * G + c; if (L >= nwg) return false;
        int wgid = (int)L; { const int q = nwg / NXCD, r = nwg % NXCD, xcd = wgid % NXCD, off = wgid / NXCD; wgid = (xcd < r ? xcd * (q + 1) : r * (q + 1) + (xcd - r) * q) + off; }
        const int nig = WGM * nN, gid = wgid / nig, fm = gid * WGM, gsz = (nM - fm) < WGM ? (nM - fm) : WGM;
        u.pm = fm + ((wgid % nig) % gsz); u.pn = (wgid % nig) / gsz; return true;
    }
    __device__ __forceinline__ void a_ready(const Unit&) const {}
    __device__ __forceinline__ void done(const Unit&) const {}
};

typedef float f32x2c __attribute__((ext_vector_type(2))); typedef __bf16 bf16x2c __attribute__((ext_vector_type(2)));
__device__ __forceinline__ unsigned cvt_pk_bf16(float lo, float hi) { const f32x2c v = {lo, hi}; return __builtin_bit_cast(unsigned, __builtin_convertvector(v, bf16x2c)); }
struct EpiF32 {
    static constexpr bool PERM = false, AFTER_DRAIN = false;
    float* C; int ldc;
    __device__ __forceinline__ void operator()(const f32x4 (&acc)[2][2][4][2], const Unit& u, int wr, int wc, int fr, int fq) const {
        const int row0 = u.pm * BM + wr * 64 + fr, col0 = u.pn * BM + wc * 32 + 4 * fq;
#pragma unroll
        for (int ai = 0; ai < 2; ++ai)
#pragma unroll
            for (int m = 0; m < 4; ++m) { float* rowp = C + (size_t)(row0 + ai * HALF + m * 16) * ldc + col0;
#pragma unroll
                for (int bj = 0; bj < 2; ++bj)
#pragma unroll
                    for (int n = 0; n < 2; ++n) *(f32x4*)(rowp + bj * HALF + n * 16) = acc[ai][bj][m][n]; }
    }
};
struct EpiBf16P {
    static constexpr bool PERM = true, AFTER_DRAIN = false;
    bf16_t* O; int ldc;
    __device__ __forceinline__ void operator()(const f32x4 (&acc)[2][2][4][2], const Unit& u, int wr, int wc, int fr, int fq) const {
        const int row0 = u.pm * BM + wr * 64 + fr, col0 = u.pn * BM + wc * 32 + 8 * fq;
#pragma unroll
        for (int ai = 0; ai < 2; ++ai)
#pragma unroll
            for (int m = 0; m < 4; ++m) { bf16_t* rowp = O + (size_t)(row0 + ai * HALF + m * 16) * ldc + col0;
#pragma unroll
                for (int bj = 0; bj < 2; ++bj) { const f32x4 v0 = acc[ai][bj][m][0], v1 = acc[ai][bj][m][1];
                    u32x4 w; w.x = cvt_pk_bf16(v0[0], v0[1]); w.y = cvt_pk_bf16(v0[2], v0[3]); w.z = cvt_pk_bf16(v1[0], v1[1]); w.w = cvt_pk_bf16(v1[2], v1[3]);
                    *(u32x4*)(rowp + bj * HALF) = w; } }
    }
};
struct EpiSwiGLU {
    static constexpr bool PERM = true, AFTER_DRAIN = false;
    bf16_t* O; int ldc;
    __device__ __forceinline__ static float silu_mul(float g, float u) { return g * u * __builtin_amdgcn_rcpf(1.0f + __builtin_amdgcn_exp2f(-1.44269504089f * g)); }
    __device__ __forceinline__ void operator()(const f32x4 (&acc)[2][2][4][2], const Unit& u, int wr, int wc, int fr, int fq) const {
        const int row0 = u.pm * BM + wr * 64 + fr, col0 = u.pn * HALF + wc * 32 + 8 * fq;
#pragma unroll
        for (int ai = 0; ai < 2; ++ai)
#pragma unroll
            for (int m = 0; m < 4; ++m) { bf16_t* rowp = O + (size_t)(row0 + ai * HALF + m * 16) * ldc + col0;
                const f32x4 g0 = acc[ai][0][m][0], g1 = acc[ai][0][m][1], u0 = acc[ai][1][m][0], u1 = acc[ai][1][m][1];
                u32x4 w; w.x = cvt_pk_bf16(silu_mul(g0[0], u0[0]), silu_mul(g0[1], u0[1])); w.y = cvt_pk_bf16(silu_mul(g0[2], u0[2]), silu_mul(g0[3], u0[3]));
                w.z = cvt_pk_bf16(silu_mul(g1[0], u1[0]), silu_mul(g1[1], u1[1])); w.w = cvt_pk_bf16(silu_mul(g1[2], u1[2]), silu_mul(g1[3], u1[3]));
                *(u32x4*)rowp = w; }
    }
};

template <class Epi, class Sched, bool ALIGN_EPI = false, bool SP2 = false>
__device__ __forceinline__ void gemm_phase(PG8_LAS unsigned char* lds, const Gemm g, const Sched& S, const Epi& E, int tid_in) {
    const int tid = tid_in, wid = __builtin_amdgcn_readfirstlane(tid >> 6), lane = tid & 63, wr = wid >> 2, wc = wid & 3, fr = lane & 15, fq = lane >> 4;
    const int K = g.K, nt = K / BK;
    unsigned voffA[2], voffB[2];
#pragma unroll
    for (int i = 0; i < 2; ++i) { int R, C; stage_rc(tid * 16 + i * 8192, R, C); const int Rb = Epi::PERM ? ((R & ~31) + perm32(R & 31)) : R;
        voffA[i] = (unsigned)(R * K + C) * 2u; voffB[i] = (unsigned)(Rb * K + C) * 2u; }
    const size_t kstep = (size_t)(BK * 2);
    const size_t hstep = (size_t)HALF * K * 2;
    const size_t tstep = 2 * hstep;
    const unsigned ldsw = (unsigned)wid * 1024u;
    const int aoff = lds_byte(wr * 64 + fr, fq * 8), boff = lds_byte(wc * 32 + fr, fq * 8);
#define PG8_SA(b, h) (((b) * 2 + (h)) * HTB)
#define PG8_SB(b, h) ((4 + (b) * 2 + (h)) * HTB)
#define PG8_STAGE(bufoff, gbase, voff) do { _Pragma("unroll") for (int _i = 0; _i < 2; ++_i) \
        __builtin_amdgcn_global_load_lds((const unsigned*)((const char*)(gbase) + (voff)[_i]), (PG8_LAS unsigned*)(lds + (bufoff) + ldsw + _i * 8192), 16, 0, 0); } while (0)
#define PG8_LDA(dst, b, h) do { _Pragma("unroll") for (int m = 0; m < 4; ++m) _Pragma("unroll") for (int k = 0; k < 2; ++k) dst[m][k] = *(const PG8_LAS bf16x8*)(lds + PG8_SA(b, h) + aoff + m * 2048 + k * 1024); } while (0)
#define PG8_LDB(dst, b, h) do { _Pragma("unroll") for (int n = 0; n < 2; ++n) _Pragma("unroll") for (int k = 0; k < 2; ++k) dst[n][k] = *(const PG8_LAS bf16x8*)(lds + PG8_SB(b, h) + boff + n * 2048 + k * 1024); } while (0)
#define PG8_MMA(ai, bj, At, Bt) do { __builtin_amdgcn_s_setprio(1); _Pragma("unroll") for (int m = 0; m < 4; ++m) _Pragma("unroll") for (int n = 0; n < 2; ++n) _Pragma("unroll") for (int k = 0; k < 2; ++k) \
        acc[ai][bj][m][n] = __builtin_amdgcn_mfma_f32_16x16x32_bf16(Bt[n][k], At[m][k], acc[ai][bj][m][n], 0, 0, 0); __builtin_amdgcn_s_setprio(0); } while (0)
#define PG8_WAIT_V(n) asm volatile("s_waitcnt vmcnt(" #n ")" ::: "memory")
#define PG8_WAIT_L(n) asm volatile("s_waitcnt lgkmcnt(" #n ")" ::: "memory")
#define PG8_BAR __builtin_amdgcn_s_barrier()
#define PG8_SCHED __builtin_amdgcn_sched_barrier(0)
    Unit cur, nxt; int ui = 0;
    if (!S.next(0, cur)) return;
    f32x4 acc[2][2][4][2];
#pragma unroll
    for (int a = 0; a < 2; ++a)
#pragma unroll
        for (int b = 0; b < 2; ++b)
#pragma unroll
            for (int m = 0; m < 4; ++m)
#pragma unroll
                for (int n = 0; n < 2; ++n) acc[a][b][m][n] = (f32x4){0.f, 0.f, 0.f, 0.f};
    bf16x8 At[4][2], B0[2][2], B1[2][2];
    const char* cA = (const char*)g.A + (size_t)cur.pm * tstep; const char* cB = (const char*)g.Bt + (size_t)cur.pn * tstep;
    S.a_ready(cur);
    if constexpr (SP2) {
        PG8_STAGE(PG8_SB(0, 0), cB, voffB); PG8_STAGE(PG8_SB(0, 1), cB + hstep, voffB); PG8_STAGE(PG8_SA(0, 0), cA, voffA); PG8_STAGE(PG8_SA(0, 1), cA + hstep, voffA);
        if (wr == 1) PG8_BAR;
        PG8_WAIT_V(2); PG8_BAR;
        PG8_STAGE(PG8_SB(1, 0), cB + kstep, voffB); PG8_STAGE(PG8_SA(1, 0), cA + kstep, voffA); PG8_STAGE(PG8_SB(1, 1), cB + hstep + kstep, voffB);
        PG8_WAIT_V(6); PG8_BAR;
    } else {
        PG8_STAGE(PG8_SB(0, 0), cB, voffB); PG8_STAGE(PG8_SA(0, 0), cA, voffA); PG8_STAGE(PG8_SB(0, 1), cB + hstep, voffB); PG8_STAGE(PG8_SA(0, 1), cA + hstep, voffA);
        if (wr == 1) PG8_BAR;
        PG8_WAIT_V(4); PG8_BAR;
        PG8_STAGE(PG8_SB(1, 0), cB + kstep, voffB); PG8_STAGE(PG8_SA(1, 0), cA + kstep, voffA); PG8_STAGE(PG8_SB(1, 1), cB + hstep + kstep, voffB);
        PG8_WAIT_V(6); PG8_BAR;
    }
    for (;;) {
        const bool has_next = S.next(ui + 1, nxt);
        const char* nA = has_next ? (const char*)g.A + (size_t)nxt.pm * tstep : cA; const char* nB = has_next ? (const char*)g.Bt + (size_t)nxt.pn * tstep : cB;
        for (int t = 0; t < nt; t += 2) {
            const bool last = (t == nt - 2);
            const char* a1 = cA + (size_t)(t + 1) * kstep;
            const char* a2 = last ? nA : cA + (size_t)(t + 2) * kstep; const char* b2 = last ? nB : cB + (size_t)(t + 2) * kstep;
            const char* a3 = a2 + kstep; const char* b3 = b2 + kstep;
            if (last && has_next) S.a_ready(nxt);
            if constexpr (SP2) {
            PG8_LDB(B0, 0, 0); PG8_LDB(B1, 0, 1); PG8_SCHED; PG8_LDA(At, 0, 0); PG8_STAGE(PG8_SA(1, 1), a1 + hstep, voffA);
            PG8_WAIT_V(8); PG8_WAIT_L(0); PG8_BAR; PG8_MMA(0, 0, At, B0); PG8_MMA(0, 1, At, B1); PG8_BAR; PG8_SCHED;
            PG8_LDA(At, 0, 1); PG8_STAGE(PG8_SB(0, 0), b2, voffB); PG8_STAGE(PG8_SB(0, 1), b2 + hstep, voffB); PG8_STAGE(PG8_SA(0, 0), a2, voffA);
            PG8_WAIT_V(8); PG8_WAIT_L(0); PG8_BAR; PG8_MMA(1, 0, At, B0); PG8_MMA(1, 1, At, B1); PG8_BAR; PG8_SCHED;
            PG8_LDB(B0, 1, 0); PG8_LDB(B1, 1, 1); PG8_SCHED; PG8_LDA(At, 1, 0); PG8_STAGE(PG8_SA(0, 1), a2 + hstep, voffA);
            PG8_WAIT_V(8); PG8_WAIT_L(0); PG8_BAR; PG8_MMA(0, 0, At, B0); PG8_MMA(0, 1, At, B1); PG8_BAR; PG8_SCHED;
            PG8_LDA(At, 1, 1); PG8_STAGE(PG8_SB(1, 0), b3, voffB); PG8_STAGE(PG8_SB(1, 1), b3 + hstep, voffB); PG8_STAGE(PG8_SA(1, 0), a3, voffA);
            PG8_WAIT_V(8); PG8_WAIT_L(0); PG8_BAR; PG8_MMA(1, 0, At, B0); PG8_MMA(1, 1, At, B1); PG8_BAR; PG8_SCHED;
            } else {
            PG8_LDB(B0, 0, 0); PG8_SCHED; PG8_LDA(At, 0, 0); PG8_STAGE(PG8_SA(1, 1), a1 + hstep, voffA);
            PG8_WAIT_L(8); PG8_BAR; PG8_WAIT_L(0); PG8_MMA(0, 0, At, B0); PG8_BAR; PG8_SCHED;
            PG8_LDB(B1, 0, 1); PG8_STAGE(PG8_SB(0, 0), b2, voffB);
            PG8_BAR; PG8_WAIT_L(0); PG8_MMA(0, 1, At, B1); PG8_BAR;
            PG8_LDA(At, 0, 1); PG8_STAGE(PG8_SA(0, 0), a2, voffA);
            PG8_BAR; PG8_WAIT_L(0); PG8_MMA(1, 0, At, B0); PG8_BAR; PG8_SCHED;
            PG8_STAGE(PG8_SB(0, 1), b2 + hstep, voffB);
            PG8_WAIT_V(6); PG8_BAR; PG8_MMA(1, 1, At, B1); PG8_BAR;
            PG8_LDB(B0, 1, 0); PG8_SCHED; PG8_LDA(At, 1, 0); PG8_STAGE(PG8_SA(0, 1), a2 + hstep, voffA);
            PG8_WAIT_L(8); PG8_BAR; PG8_WAIT_L(0); PG8_MMA(0, 0, At, B0); PG8_BAR; PG8_SCHED;
            PG8_LDB(B1, 1, 1); PG8_STAGE(PG8_SB(1, 0), b3, voffB);
            PG8_BAR; PG8_WAIT_L(0); PG8_MMA(0, 1, At, B1); PG8_BAR;
            PG8_LDA(At, 1, 1); PG8_STAGE(PG8_SA(1, 0), a3, voffA);
            PG8_BAR; PG8_WAIT_L(0); PG8_MMA(1, 0, At, B0); PG8_BAR; PG8_SCHED;
            PG8_STAGE(PG8_SB(1, 1), b3 + hstep, voffB);
            PG8_WAIT_V(6); PG8_BAR; PG8_MMA(1, 1, At, B1); PG8_BAR;
            }
        }
        if constexpr (ALIGN_EPI) { if (wr == 0) PG8_BAR; }
        if constexpr (!Epi::AFTER_DRAIN) { E(acc, cur, wr, wc, fr, fq); S.done(cur); }
        if (!has_next) break;
#pragma unroll
        for (int a = 0; a < 2; ++a)
#pragma unroll
            for (int b = 0; b < 2; ++b)
#pragma unroll
                for (int m = 0; m < 4; ++m)
#pragma unroll
                    for (int n = 0; n < 2; ++n) acc[a][b][m][n] = (f32x4){0.f, 0.f, 0.f, 0.f};
        cur = nxt; cA = nA; cB = nB; ++ui;
        if constexpr (ALIGN_EPI) { if (wr == 1) PG8_BAR; }
    }
    PG8_WAIT_V(0);
    if constexpr (!ALIGN_EPI) { if (wr == 0) PG8_BAR; }
    PG8_BAR;
    if constexpr (Epi::AFTER_DRAIN) { E.fused(acc, cur, wr, wc, fr, fq, lds, wid, lane); S.done(cur); }
#undef PG8_SA
#undef PG8_SB
#undef PG8_STAGE
#undef PG8_LDA
#undef PG8_LDB
#undef PG8_MMA
#undef PG8_WAIT_V
#undef PG8_WAIT_L
#undef PG8_BAR
#undef PG8_SCHED
}
}

#define LAS __attribute__((address_space(3)))
typedef unsigned short bf16_t;
typedef float f32x4 __attribute__((ext_vector_type(4)));
typedef float f32x2 __attribute__((ext_vector_type(2)));
typedef unsigned u32x4 __attribute__((ext_vector_type(4)));
typedef unsigned u32x2 __attribute__((ext_vector_type(2)));
constexpr int NWAVES = 8, NTHR = 512;
constexpr int D = 2048, SEQ = 4096, M = 8192, DEPTH = 4, DFF = 5632, NGU = 2 * DFF, NIN = 5900, NINP = 6144;
constexpr int PC_SSM = 0, PC_AQ = 512, PC_AK = 1280, PC_AV = 2048, PC_DQKV = 2816, PC_DZ = 5120, PC_DA = 5888, PC_DB = 5894;
constexpr float EPS = 1e-6f;
enum { I_X = 0, I_GAINS, I_WG, I_WU, I_WD, I_WIN, I_WOUT, I_LRE, I_LIM, I_BRE, I_BIM, I_CRE, I_CIM, I_SD, I_LOGDT, I_GLUW, I_GLUB, I_SGAIN, I_CONVW, I_ALOG, I_DTB, I_DNG, I_ATG, I_RELB, N_IN };
constexpr size_t MiB = 1ull << 20;
constexpr size_t WS_CTL = 0, CTL_ZERO_BYTES = 1 * MiB;
constexpr size_t WS_WGU = 1 * MiB;
constexpr size_t WS_WD = WS_WGU + 352 * MiB;
constexpr size_t WS_WIN = WS_WD + 176 * MiB;
constexpr size_t WS_WOUT = WS_WIN + 96 * MiB;
constexpr size_t WS_WGLU = WS_WOUT + 32 * MiB;
constexpr size_t WS_X = WS_WGLU + 2 * MiB;
constexpr size_t WS_H = WS_X + 64 * MiB;
constexpr size_t WS_ACT = WS_H + 32 * MiB;
constexpr size_t WS_Y = WS_ACT + 88 * MiB;
constexpr size_t WS_PROJ = WS_Y + 64 * MiB;
constexpr size_t WS_MIX = WS_PROJ + 192 * MiB;
constexpr size_t WS_SSME = WS_MIX + 32 * MiB;
constexpr size_t WS_YG = WS_SSME + 2 * MiB;
constexpr size_t WS_YGB = WS_YG + 16 * MiB;
constexpr size_t WS_Z = WS_YGB + 8 * MiB;
constexpr size_t WS_DQ = WS_Z + 16 * MiB;
constexpr size_t WS_DK = WS_DQ + 24 * MiB;
constexpr size_t WS_DV = WS_DK + 24 * MiB;
constexpr size_t WS_DO = WS_DV + 24 * MiB;
constexpr size_t WS_DBG = WS_DO + 24 * MiB;
constexpr size_t WS_DWN = WS_DQ;
constexpr size_t WS_DQD = WS_DWN + 12 * MiB;
constexpr size_t WS_DKT = WS_DQD + 12 * MiB;
constexpr size_t WS_DAT = WS_DKT + 12 * MiB;
constexpr size_t WS_DUD = WS_DAT + 6 * MiB;
constexpr size_t WS_DCD = WS_DUD + 24 * MiB;
static_assert(WS_DCD + 1 * MiB <= WS_DO, "DN overlay");
constexpr size_t WS_AO = WS_DBG + 1 * MiB;
constexpr size_t WS_ALSE = WS_AO + 72 * MiB;
constexpr size_t WS_DSS = WS_ALSE + 1 * MiB;
constexpr size_t WS_DVN = WS_DSS + 24 * MiB;
constexpr size_t WS_END = WS_DVN + 12 * MiB;
constexpr int CW_BAR = 4096;
constexpr int LDS_BYTES = 155648, MISC_OFF = LDS_BYTES - 256;

#define XB_TMO      128
#define XB_XCNT(j)  (256  + 64 * (j))
#define XB_XSUB(j)  (1280 + 64 * (j))
#define XB_XGEN(j)  (2304 + 64 * (j))
#define XB_TOP      3328
#define XB_TOPGEN   3392
#define XCD_BAR_WORDS 3456
#define XB_SPIN_CAP (1u << 18)

__device__ __forceinline__ unsigned xb_ld(unsigned* p)              { return __hip_atomic_load(p, __ATOMIC_RELAXED, __HIP_MEMORY_SCOPE_AGENT); }
__device__ __forceinline__ unsigned xb_add(unsigned* p, unsigned v) { return __hip_atomic_fetch_add(p, v, __ATOMIC_RELAXED, __HIP_MEMORY_SCOPE_AGENT); }
__device__ __forceinline__ unsigned xb_xcc_id() { return (unsigned)__builtin_amdgcn_s_getreg((3 << 11) | 20) & 0xFu; }
#define XB_SPIN(cond, bar) do { unsigned _sp = 0; while (cond) { __builtin_amdgcn_s_sleep(1); \
    if ((++_sp & 255u) == 0u) { if (xb_ld(&(bar)[XB_TMO])) break; if (_sp > XB_SPIN_CAP) { atomicAdd(&(bar)[XB_TMO], 1u); break; } } } } while (0)

struct XcdBarrier {
    unsigned* bar; unsigned x;
    volatile LAS unsigned* st;
};

__device__ __forceinline__ XcdBarrier xcd_barrier_post(unsigned* bar, volatile LAS unsigned* st) {
    XcdBarrier b; b.bar = bar; b.x = xb_xcc_id(); b.st = st;
    if (threadIdx.x == 0) (void)xb_add(&bar[XB_XCNT(b.x)], 1u);
    return b;
}
__device__ __forceinline__ void xcd_barrier_complete(unsigned* bar, unsigned x, unsigned& nloc, unsigned& nx) {
    const unsigned G = gridDim.x * gridDim.y * gridDim.z;
    unsigned sum, cnt, mine, sp = 0u;
    for (;;) {
        sum = 0u; cnt = 0u; mine = 0u;
#pragma unroll
        for (unsigned j = 0; j < 16; ++j) { const unsigned c = xb_ld(&bar[XB_XCNT(j)]); sum += c; cnt += (c > 0u) ? 1u : 0u; mine = (j == x) ? c : mine; }
        if (sum == G) break;
        __builtin_amdgcn_s_sleep(1);
        if ((++sp & 255u) == 0u) { if (xb_ld(&bar[XB_TMO])) break; if (sp > XB_SPIN_CAP) { atomicAdd(&bar[XB_TMO], 1u); break; } }
    }
    nloc = mine > 0u ? mine : 1u; nx = cnt > 0u ? cnt : 1u;
}

__device__ __forceinline__ void xcd_barrier(const XcdBarrier& b) {
    asm volatile("s_waitcnt vmcnt(0)" ::: "memory");
    __syncthreads();
    if (threadIdx.x == 0) {
        unsigned bz_ = 0; asm volatile("" : "+s"(bz_)); unsigned* bar = b.bar + bz_;
        __builtin_amdgcn_s_waitcnt(0);
        unsigned nloc = b.st[0], nx = b.st[1];
        if (nloc == 0u) { xcd_barrier_complete(bar, b.x, nloc, nx); b.st[0] = nloc; b.st[1] = nx; }
        const unsigned old = xb_add(&bar[XB_XSUB(b.x)], 1u);
        const unsigned gen = old / nloc;
        if (old + 1u == (gen + 1u) * nloc) {
            __builtin_amdgcn_fence(__ATOMIC_RELEASE, "agent");
            asm volatile("s_waitcnt vmcnt(0)" ::: "memory");
            const unsigned og = xb_add(&bar[XB_TOP], 1u);
            const unsigned tg = og / nx;
            if (og + 1u == (tg + 1u) * nx) xb_add(&bar[XB_TOPGEN], 1u);
            else XB_SPIN(xb_ld(&bar[XB_TOPGEN]) == tg, bar);
            __builtin_amdgcn_fence(__ATOMIC_ACQUIRE, "agent");
            xb_add(&bar[XB_XGEN(b.x)], 1u);
            asm volatile("s_waitcnt vmcnt(0)" ::: "memory");
        } else {
            XB_SPIN(xb_ld(&bar[XB_XGEN(b.x)]) == gen, bar);
            __builtin_amdgcn_fence(__ATOMIC_ACQUIRE, "agent");
            asm volatile("s_waitcnt vmcnt(0)" ::: "memory");
        }
    }
    __syncthreads();
}

struct Args { const float* in[24]; float* out; unsigned char* ws; int ph_lo, ph_hi; };
__device__ __forceinline__ float shx(int lane, float v, int o) { return __int_as_float(__builtin_amdgcn_ds_bpermute((lane ^ o) << 2, __float_as_int(v))); }
__device__ __forceinline__ float wave_sum(int lane, float v) {
#pragma unroll
    for (int o = 1; o < 64; o <<= 1) v += shx(lane, v, o);
    return v;
}
__device__ __forceinline__ float wave_max(int lane, float v) {
#pragma unroll
    for (int o = 1; o < 64; o <<= 1) v = fmaxf(v, shx(lane, v, o));
    return v;
}
__device__ __forceinline__ unsigned pk2(float lo, float hi) { return pg8::cvt_pk_bf16(lo, hi); }
__device__ __forceinline__ float bf_lo(unsigned w) { return __uint_as_float(w << 16); }
__device__ __forceinline__ float bf_hi(unsigned w) { return __uint_as_float(w & 0xffff0000u); }
__device__ __forceinline__ float sigmoidf_(float x) { return 1.0f / (1.0f + expf(-x)); }
__device__ __forceinline__ float siluf_(float x) { return x / (1.0f + expf(-x)); }
#define LDS_WAIT() asm volatile("s_waitcnt lgkmcnt(0)" ::: "memory")

__device__ __forceinline__ void transpose_item(const float* W, int ldw, int k0, int ns0, int nvalid, bf16_t* WT, int K, int nd0, LAS float* scr, int lane, bool vec4) {
    if (vec4) { const int c4 = lane & 7, kr = lane >> 3;
#pragma unroll
        for (int i = 0; i < 8; ++i) { const int kk = 8 * i + kr; const f32x4 v = *(const f32x4*)(W + (size_t)(k0 + kk) * ldw + ns0 + 4 * c4);
            scr[kk * 33 + 4 * c4] = v.x; scr[kk * 33 + 4 * c4 + 1] = v.y; scr[kk * 33 + 4 * c4 + 2] = v.z; scr[kk * 33 + 4 * c4 + 3] = v.w; } }
    else { const int c = lane & 31;
#pragma unroll 8
        for (int i = 0; i < 32; ++i) { const int kk = 2 * i + (lane >> 5); scr[kk * 33 + c] = (c < nvalid) ? W[(size_t)(k0 + kk) * ldw + ns0 + c] : 0.f; } }
    LDS_WAIT(); asm volatile("" ::: "memory");
    const int c8 = lane & 7;
#pragma unroll
    for (int j = 0; j < 4; ++j) { const int n = (lane >> 3) + 8 * j; const LAS float* s = scr + (8 * c8) * 33 + n;
        u32x4 o; o.x = pk2(s[0 * 33], s[1 * 33]); o.y = pk2(s[2 * 33], s[3 * 33]); o.z = pk2(s[4 * 33], s[5 * 33]); o.w = pk2(s[6 * 33], s[7 * 33]);
        *(u32x4*)(WT + (size_t)(nd0 + n) * K + k0 + 8 * c8) = o; }
    LDS_WAIT(); asm volatile("" ::: "memory");
}
__device__ __forceinline__ void rmsnorm_row_bf16(const float* xrow, const float* gain, bf16_t* orow, int lane) {
    f32x4 v[8]; float ss = 0.f;
#pragma unroll
    for (int j = 0; j < 8; ++j) { v[j] = ((const f32x4*)xrow)[lane + 64 * j]; ss += (v[j].x * v[j].x + v[j].y * v[j].y) + (v[j].z * v[j].z + v[j].w * v[j].w); }
    const float r = rsqrtf(wave_sum(lane, ss) * (1.f / D) + EPS);
#pragma unroll
    for (int j = 0; j < 8; ++j) { const f32x4 g = ((const f32x4*)gain)[lane + 64 * j]; u32x2 w; w.x = pk2(v[j].x * r * g.x, v[j].y * r * g.y); w.y = pk2(v[j].z * r * g.z, v[j].w * r * g.w);
        ((u32x2*)orow)[lane + 64 * j] = w; }
}
constexpr int CV_GU = 2 * 352 * 32, CV_D = 2 * 64 * 88, CV_IN = 192 * 32, CV_OUT = 64 * 32, CV_GLU = 16 * 8, CV_ITEMS = CV_GU + CV_D + CV_IN + CV_OUT + CV_GLU;
__device__ __forceinline__ void convert_item(const Args& a, unsigned char* ws, int L, int it, LAS float* scr, int lane) {
    int r = it;
    if (r < CV_GU) { const int mi = L * 2 + r / (352 * 32), q = r % (352 * 32), kb = q / 352, ng = q % 352, nd0 = 32 * ng, pn = nd0 >> 8, wi = nd0 & 255, bj = wi >> 7, i = wi & 127;
        const float* W = (bj ? a.in[I_WU] : a.in[I_WG]) + (size_t)mi * D * DFF;
        transpose_item(W, DFF, 64 * kb, 128 * pn + i, 32, (bf16_t*)(ws + WS_WGU) + (size_t)mi * NGU * D, D, nd0, scr, lane, true); return; }
    r -= CV_GU;
    if (r < CV_D) { const int mi = L * 2 + r / (64 * 88), q = r % (64 * 88), kb = q / 64, ng = q % 64;
        transpose_item(a.in[I_WD] + (size_t)mi * DFF * D, D, 64 * kb, 32 * ng, 32, (bf16_t*)(ws + WS_WD) + (size_t)mi * D * DFF, DFF, 32 * ng, scr, lane, true); return; }
    r -= CV_D;
    if (r < CV_IN) { const int kb = r / 192, ng = r % 192; int nv = NIN - 32 * ng; nv = nv > 32 ? 32 : (nv < 0 ? 0 : nv);
        transpose_item(a.in[I_WIN] + (size_t)L * D * NIN, NIN, 64 * kb, 32 * ng, nv, (bf16_t*)(ws + WS_WIN) + (size_t)L * NINP * D, D, 32 * ng, scr, lane, nv == 32); return; }
    r -= CV_IN;
    if (r < CV_OUT) { const int kb = r / 64, ng = r % 64;
        transpose_item(a.in[I_WOUT] + (size_t)L * D * D, D, 64 * kb, 32 * ng, 32, (bf16_t*)(ws + WS_WOUT) + (size_t)L * D * D, D, 32 * ng, scr, lane, true); return; }
    r -= CV_OUT;
    { const int kb = r / 16, ng = r % 16;
        transpose_item(a.in[I_GLUW] + (size_t)L * 512 * 512, 512, 64 * kb, 32 * ng, 32, (bf16_t*)(ws + WS_WGLU) + (size_t)L * 512 * 512, 512, 32 * ng, scr, lane, true); }
}
__device__ __forceinline__ void p0_prologue(const Args& a, unsigned char* ws, LAS unsigned char* lds, int blk, int G, int tid) {
    const int lane = tid & 63, wave = __builtin_amdgcn_readfirstlane(tid >> 6), gw = blk * NWAVES + wave, ngw = G * NWAVES;
    LAS float* scr = (LAS float*)(lds + wave * 16384);
    for (int it = gw; it < CV_ITEMS; it += ngw) convert_item(a, ws, 0, it, scr, lane);
    for (int m = gw; m < M; m += ngw) rmsnorm_row_bf16(a.in[I_X] + (size_t)m * D, a.in[I_GAINS], (bf16_t*)(ws + WS_H) + (size_t)m * D, lane);
}
constexpr int CW_Q = 8192, CW_DONE = 8192 + 64 * 8;
__device__ __forceinline__ void conv_slot(const Args& a, unsigned char* ws, int L, int slot, unsigned target, LAS unsigned char* lds, volatile LAS unsigned* MISC, int tid) {
    if (L >= DEPTH) return;
    const int lane = tid & 63, wave = __builtin_amdgcn_readfirstlane(tid >> 6);
    unsigned* q = (unsigned*)(ws + WS_CTL) + CW_Q + 64 * L; unsigned* dn = (unsigned*)(ws + WS_CTL) + CW_DONE + 64 * slot;
    LAS float* scr = (LAS float*)(lds + wave * 16384);
    __syncthreads();
    if (target && tid == 0) __hip_atomic_fetch_add(dn, 1u, __ATOMIC_RELAXED, __HIP_MEMORY_SCOPE_AGENT);
    for (;;) {
        if (tid == 0) { unsigned base = 0xffffffffu;
            if (!target || __hip_atomic_load(dn, __ATOMIC_RELAXED, __HIP_MEMORY_SCOPE_AGENT) < target) base = __hip_atomic_fetch_add(q, 8u, __ATOMIC_RELAXED, __HIP_MEMORY_SCOPE_AGENT);
            MISC[16] = base; }
        __syncthreads();
        const unsigned base = MISC[16];
        __syncthreads();
        if (base >= (unsigned)CV_ITEMS) break;
        const int it = (int)base + wave;
        if (it < CV_ITEMS) convert_item(a, ws, L, it, scr, lane);
    }
}

__device__ __forceinline__ void bf8_to_f32(const u32x4 w, float (&o)[8]) { o[0] = bf_lo(w.x); o[1] = bf_hi(w.x); o[2] = bf_lo(w.y); o[3] = bf_hi(w.y); o[4] = bf_lo(w.z); o[5] = bf_hi(w.z); o[6] = bf_lo(w.w); o[7] = bf_hi(w.w); }
template <bool SRC_F32, bool DST_F32>
__device__ __forceinline__ void thin_phase(const void* xsrc, void* xdst, const bf16_t* y, const float* gpost, float scale, const float* gpre, bf16_t* h, int blk, int G, int tid) {
    const int lane = tid & 63, wave = __builtin_amdgcn_readfirstlane(tid >> 6), gw = blk * NWAVES + wave, ngw = G * NWAVES;
    for (int m = gw; m < M; m += ngw) {
        float yv[4][8], xv[4][8]; float ss = 0.f;
#pragma unroll
        for (int j = 0; j < 4; ++j) { bf8_to_f32(((const u32x4*)(y + (size_t)m * D))[lane + 64 * j], yv[j]);
            if (SRC_F32) { const f32x4 a0 = ((const f32x4*)((const float*)xsrc + (size_t)m * D))[(lane + 64 * j) * 2], a1 = ((const f32x4*)((const float*)xsrc + (size_t)m * D))[(lane + 64 * j) * 2 + 1];
                xv[j][0] = a0.x; xv[j][1] = a0.y; xv[j][2] = a0.z; xv[j][3] = a0.w; xv[j][4] = a1.x; xv[j][5] = a1.y; xv[j][6] = a1.z; xv[j][7] = a1.w; }
            else bf8_to_f32(((const u32x4*)((const bf16_t*)xsrc + (size_t)m * D))[lane + 64 * j], xv[j]);
#pragma unroll
            for (int i = 0; i < 8; ++i) ss += yv[j][i] * yv[j][i]; }
        const float r1 = rsqrtf(wave_sum(lane, ss) * (1.f / D) + EPS) * scale; float s2 = 0.f;
#pragma unroll
        for (int j = 0; j < 4; ++j) { const f32x4 g0 = ((const f32x4*)gpost)[(lane + 64 * j) * 2], g1 = ((const f32x4*)gpost)[(lane + 64 * j) * 2 + 1]; const float gg[8] = {g0.x, g0.y, g0.z, g0.w, g1.x, g1.y, g1.z, g1.w};
#pragma unroll
            for (int i = 0; i < 8; ++i) { xv[j][i] += yv[j][i] * r1 * gg[i]; s2 += xv[j][i] * xv[j][i]; }
            if (DST_F32) { ((f32x4*)((float*)xdst + (size_t)m * D))[(lane + 64 * j) * 2] = (f32x4){xv[j][0], xv[j][1], xv[j][2], xv[j][3]}; ((f32x4*)((float*)xdst + (size_t)m * D))[(lane + 64 * j) * 2 + 1] = (f32x4){xv[j][4], xv[j][5], xv[j][6], xv[j][7]}; }
            else { u32x4 w; w.x = pk2(xv[j][0], xv[j][1]); w.y = pk2(xv[j][2], xv[j][3]); w.z = pk2(xv[j][4], xv[j][5]); w.w = pk2(xv[j][6], xv[j][7]); ((u32x4*)((bf16_t*)xdst + (size_t)m * D))[lane + 64 * j] = w; } }
        if (h) { const float r2 = rsqrtf(wave_sum(lane, s2) * (1.f / D) + EPS);
#pragma unroll
            for (int j = 0; j < 4; ++j) { const f32x4 g0 = ((const f32x4*)gpre)[(lane + 64 * j) * 2], g1 = ((const f32x4*)gpre)[(lane + 64 * j) * 2 + 1];
                u32x4 w; w.x = pk2(xv[j][0] * r2 * g0.x, xv[j][1] * r2 * g0.y); w.y = pk2(xv[j][2] * r2 * g0.z, xv[j][3] * r2 * g0.w); w.z = pk2(xv[j][4] * r2 * g1.x, xv[j][5] * r2 * g1.y); w.w = pk2(xv[j][6] * r2 * g1.z, xv[j][7] * r2 * g1.w);
                ((u32x4*)(h + (size_t)m * D))[lane + 64 * j] = w; } }
    }
}

__device__ __forceinline__ void ssm_lambda(const Args& a, int l, int g, int p, float& ar, float& ai, float& cr, float& ci) {
    const float lr = a.in[I_LRE][(l * 32 + g) * 64 + p], li = a.in[I_LIM][(l * 32 + g) * 64 + p], dt = expf(a.in[I_LOGDT][l * 32 + g]);
    const float x = lr * dt, yy = li * dt; float sn, cs; sincosf(yy, &sn, &cs); const float mag = expf(x);
    ar = mag * cs; ai = mag * sn;
    const float sh = sinf(0.5f * yy); const float er = expm1f(x) * cs - 2.f * sh * sh, ei = ai;
    const float den = 1.f / (lr * lr + li * li); cr = (er * lr + ei * li) * den; ci = (ei * lr - er * li) * den;
}
__device__ __forceinline__ void ssm_local(const Args& a, unsigned char* ws, int l, int blk, int G, int tid, LAS unsigned char* lds) {
    const int lane = tid & 63, wave = __builtin_amdgcn_readfirstlane(tid >> 6), gw = blk * NWAVES + wave, ngw = G * NWAVES;
    const bf16_t* proj = (const bf16_t*)(ws + WS_PROJ); f32x2* E = (f32x2*)(ws + WS_SSME);
    LAS f32x4* ubuf = (LAS f32x4*)(lds + wave * 4096);
    for (int wu = gw; wu < 4096; wu += ngw) {
        const int b = wu >> 11, g = (wu >> 6) & 31, ch = wu & 63;
        const bf16_t* up = proj + (size_t)(b * SEQ + ch * 64) * NINP + PC_SSM + g * 16;
        const u32x4 ub0 = *(const u32x4*)(up + (size_t)lane * NINP), ub1 = *(const u32x4*)(up + (size_t)lane * NINP + 8);
        float ar, ai, cr, ci; ssm_lambda(a, l, g, lane, ar, ai, cr, ci);
        float bbr[16], bbi[16];
        { const f32x4* br = (const f32x4*)(a.in[I_BRE] + ((size_t)(l * 32 + g) * 64 + lane) * 16); const f32x4* bi = (const f32x4*)(a.in[I_BIM] + ((size_t)(l * 32 + g) * 64 + lane) * 16);
#pragma unroll
          for (int q = 0; q < 4; ++q) { const f32x4 x = br[q], y = bi[q];
#pragma unroll
              for (int e = 0; e < 4; ++e) { bbr[4 * q + e] = cr * x[e] - ci * y[e]; bbi[4 * q + e] = cr * y[e] + ci * x[e]; } } }
        { float t0[8], t1[8]; bf8_to_f32(ub0, t0); bf8_to_f32(ub1, t1);
          ubuf[lane * 4 + 0] = (f32x4){t0[0], t0[1], t0[2], t0[3]}; ubuf[lane * 4 + 1] = (f32x4){t0[4], t0[5], t0[6], t0[7]}; ubuf[lane * 4 + 2] = (f32x4){t1[0], t1[1], t1[2], t1[3]}; ubuf[lane * 4 + 3] = (f32x4){t1[4], t1[5], t1[6], t1[7]}; }
        LDS_WAIT(); asm volatile("" ::: "memory");
        float sr = 0.f, si = 0.f;
#pragma unroll 4
        for (int t = 0; t < 64; ++t) { float bur = 0.f, bui = 0.f;
#pragma unroll
            for (int q = 0; q < 4; ++q) { const f32x4 u = ubuf[t * 4 + q];
#pragma unroll
                for (int e = 0; e < 4; ++e) { bur += bbr[4 * q + e] * u[e]; bui += bbi[4 * q + e] * u[e]; } }
            const float nr = ar * sr - ai * si + bur, ni = ar * si + ai * sr + bui; sr = nr; si = ni;
        }
        E[(size_t)wu * 64 + lane] = (f32x2){sr, si};
        LDS_WAIT(); asm volatile("" ::: "memory");
    }
}
__device__ __forceinline__ float gelu_tanh(float y) { return 0.5f * y * (1.0f + tanhf(0.7978845608028654f * (y + 0.044715f * y * y * y))); }
constexpr int SSM_WLDS = 4096 + 8 * 65 * 8 + 16 * 65 * 8;
__device__ __forceinline__ void ssm_final_unit(const Args& a, unsigned char* ws, int l, int wu, LAS unsigned char* wlds, int lane) {
    const bf16_t* proj = (const bf16_t*)(ws + WS_PROJ); const f32x2* E = (const f32x2*)(ws + WS_SSME);
    float* YG = (float*)(ws + WS_YG); bf16_t* YGB = (bf16_t*)(ws + WS_YGB);
    LAS f32x4* ubuf = (LAS f32x4*)wlds; LAS f32x2* sbuf = (LAS f32x2*)(wlds + 4096); LAS f32x2* cbuf = sbuf + 8 * 65;
    const int b = wu >> 11, g = (wu >> 6) & 31, ch = wu & 63;
    const size_t row0 = (size_t)b * SEQ + ch * 64;
    const bf16_t* up = proj + row0 * NINP + PC_SSM + g * 16;
    const u32x4 ub0 = *(const u32x4*)(up + (size_t)lane * NINP), ub1 = *(const u32x4*)(up + (size_t)lane * NINP + 8);
    float ar, ai, cr, ci; ssm_lambda(a, l, g, lane, ar, ai, cr, ci);
    float bbr[16], bbi[16];
    { const f32x4* br = (const f32x4*)(a.in[I_BRE] + ((size_t)(l * 32 + g) * 64 + lane) * 16); const f32x4* bi = (const f32x4*)(a.in[I_BIM] + ((size_t)(l * 32 + g) * 64 + lane) * 16);
#pragma unroll
      for (int q = 0; q < 4; ++q) { const f32x4 x = br[q], y = bi[q];
#pragma unroll
          for (int e = 0; e < 4; ++e) { bbr[4 * q + e] = cr * x[e] - ci * y[e]; bbi[4 * q + e] = cr * y[e] + ci * x[e]; } } }
#pragma unroll
    for (int c = 0; c < 16; ++c) cbuf[c * 65 + lane] = (f32x2){a.in[I_CRE][((size_t)(l * 32 + g) * 16 + c) * 64 + lane], a.in[I_CIM][((size_t)(l * 32 + g) * 16 + c) * 64 + lane]};
    { float t0[8], t1[8]; bf8_to_f32(ub0, t0); bf8_to_f32(ub1, t1);
      ubuf[lane * 4 + 0] = (f32x4){t0[0], t0[1], t0[2], t0[3]}; ubuf[lane * 4 + 1] = (f32x4){t0[4], t0[5], t0[6], t0[7]}; ubuf[lane * 4 + 2] = (f32x4){t1[0], t1[1], t1[2], t1[3]}; ubuf[lane * 4 + 3] = (f32x4){t1[4], t1[5], t1[6], t1[7]}; }
    float pr = ar, pi = ai;
#pragma unroll
    for (int q = 0; q < 6; ++q) { const float nr = pr * pr - pi * pi, ni = 2.f * pr * pi; pr = nr; pi = ni; }
    float sr = 0.f, si = 0.f;
    { const f32x2* e = E + (size_t)(wu - ch) * 64 + lane;
#pragma unroll 4
      for (int m2 = 0; m2 < ch; ++m2) { const f32x2 ev = e[(size_t)m2 * 64]; const float nr = pr * sr - pi * si + ev.x, ni = pr * si + pi * sr + ev.y; sr = nr; si = ni; } }
    const int c = lane & 15, tq = lane >> 4;
    const float dsk = a.in[I_SD][l * 512 + g * 16 + c];
    LDS_WAIT(); asm volatile("" ::: "memory");
    for (int tg = 0; tg < 8; ++tg) {
#pragma unroll
        for (int tt = 0; tt < 8; ++tt) { float bur = 0.f, bui = 0.f;
#pragma unroll
            for (int q = 0; q < 4; ++q) { const f32x4 u = ubuf[(tg * 8 + tt) * 4 + q];
#pragma unroll
                for (int e = 0; e < 4; ++e) { bur += bbr[4 * q + e] * u[e]; bui += bbi[4 * q + e] * u[e]; } }
            const float nr = ar * sr - ai * si + bur, ni = ar * si + ai * sr + bui; sr = nr; si = ni;
            sbuf[tt * 65 + lane] = (f32x2){sr, si};
        }
        LDS_WAIT(); asm volatile("" ::: "memory");
        float y0 = 0.f, y1 = 0.f;
#pragma unroll 8
        for (int p = 0; p < 64; ++p) { const f32x2 cc = cbuf[c * 65 + p]; const f32x2 s0 = sbuf[tq * 65 + p], s1 = sbuf[(tq + 4) * 65 + p];
            y0 += cc.x * s0.x - cc.y * s0.y; y1 += cc.x * s1.x - cc.y * s1.y; }
        LDS_WAIT(); asm volatile("" ::: "memory");
        const float yy[2] = {y0, y1};
#pragma unroll
        for (int j = 0; j < 2; ++j) { const int t = tg * 8 + tq + 4 * j; const float u = ((LAS float*)ubuf)[t * 16 + c]; const float v = gelu_tanh(yy[j] + dsk * u);
            YG[(row0 + t) * 512 + g * 16 + c] = v; YGB[(row0 + t) * 512 + g * 16 + c] = (bf16_t)(pk2(v, 0.f) & 0xffffu); }
    }
    LDS_WAIT(); asm volatile("" ::: "memory");
}

__device__ __forceinline__ void mix_phase(const Args& a, unsigned char* ws, int l, int blk, int G, int tid) {
    const int lane = tid & 63, wave = __builtin_amdgcn_readfirstlane(tid >> 6), gw = blk * NWAVES + wave, ngw = G * NWAVES;
    const bf16_t* proj = (const bf16_t*)(ws + WS_PROJ); const float* YG = (const float*)(ws + WS_YG); const float* Z = (const float*)(ws + WS_Z);
    const float* DO = (const float*)(ws + WS_DO); const float* AO = (const float*)(ws + WS_AO); const float* ALSE = (const float*)(ws + WS_ALSE);
    bf16_t* MIX = (bf16_t*)(ws + WS_MIX);
    const float* glub = a.in[I_GLUB] + l * 512; const float* sg = a.in[I_SGAIN] + l * 512; const float* dng = a.in[I_DNG] + l * 128; const float* atg = a.in[I_ATG] + l * 768;
    for (int m = gw; m < M; m += ngw) {
        { float v[8]; float ss = 0.f; const f32x4* yp = (const f32x4*)(YG + (size_t)m * 512 + 8 * lane); const f32x4* zp = (const f32x4*)(Z + (size_t)m * 512 + 8 * lane); const f32x4* bp = (const f32x4*)(glub + 8 * lane);
#pragma unroll
          for (int q = 0; q < 2; ++q) { const f32x4 y = yp[q], z = zp[q], bb = bp[q];
#pragma unroll
              for (int e = 0; e < 4; ++e) { v[4 * q + e] = y[e] * sigmoidf_(z[e] + bb[e]); ss += v[4 * q + e] * v[4 * q + e]; } }
          const float r = rsqrtf(wave_sum(lane, ss) * (1.f / 512.f) + EPS); const f32x4* gp = (const f32x4*)(sg + 8 * lane); const f32x4 g0 = gp[0], g1 = gp[1];
          u32x4 w; w.x = pk2(v[0] * r * g0.x, v[1] * r * g0.y); w.y = pk2(v[2] * r * g0.z, v[3] * r * g0.w); w.z = pk2(v[4] * r * g1.x, v[5] * r * g1.y); w.w = pk2(v[6] * r * g1.z, v[7] * r * g1.w);
          *(u32x4*)(MIX + (size_t)m * D + 8 * lane) = w; }
#pragma unroll
        for (int h = 0; h < 6; ++h) { const f32x2 o = *(const f32x2*)(DO + (size_t)m * 768 + h * 128 + 2 * lane); const unsigned zw = *(const unsigned*)(proj + (size_t)m * NINP + PC_DZ + h * 128 + 2 * lane); const f32x2 z = {bf_lo(zw), bf_hi(zw)};
            const float r = rsqrtf(wave_sum(lane, o.x * o.x + o.y * o.y) * (1.f / 128.f) + EPS); const f32x2 g = *(const f32x2*)(dng + 2 * lane);
            *(unsigned*)(MIX + (size_t)m * D + 512 + h * 128 + 2 * lane) = pk2(o.x * r * g.x * siluf_(z.x), o.y * r * g.y * siluf_(z.y)); }
        { float oa[6][2]; float ss = 0.f;
#pragma unroll
          for (int h = 0; h < 6; ++h) { const float l0 = ALSE[(size_t)m * 8 + h], l1 = ALSE[(size_t)(M + m) * 8 + h], l2 = ALSE[(size_t)(2 * M + m) * 8 + h];
              const float mx = fmaxf(l0, fmaxf(l1, l2)); const float w0 = expf(l0 - mx), w1 = expf(l1 - mx), w2 = expf(l2 - mx), inv = 1.f / (w0 + w1 + w2);
              const f32x2 a0 = *(const f32x2*)(AO + (size_t)m * 768 + h * 128 + 2 * lane), a1 = *(const f32x2*)(AO + (size_t)(M + m) * 768 + h * 128 + 2 * lane), a2 = *(const f32x2*)(AO + (size_t)(2 * M + m) * 768 + h * 128 + 2 * lane);
              oa[h][0] = (w0 * a0.x + w1 * a1.x + w2 * a2.x) * inv; oa[h][1] = (w0 * a0.y + w1 * a1.y + w2 * a2.y) * inv; ss += oa[h][0] * oa[h][0] + oa[h][1] * oa[h][1]; }
          const float r = rsqrtf(wave_sum(lane, ss) * (1.f / 768.f) + EPS);
#pragma unroll
          for (int h = 0; h < 6; ++h) { const f32x2 g = *(const f32x2*)(atg + h * 128 + 2 * lane);
              *(unsigned*)(MIX + (size_t)m * D + 1280 + h * 128 + 2 * lane) = pk2(oa[h][0] * r * g.x, oa[h][1] * r * g.y); } }
    }
}

typedef pg8::StaticOrder GemmOrder;
typedef short bf16x8 __attribute__((ext_vector_type(8)));
__device__ __forceinline__ int kperm(int k) { return (k & ~31) + 8 * ((k & 15) >> 2) + 4 * ((k >> 4) & 1) + (k & 3); }
__device__ __forceinline__ bf16x8 pack8(const f32x4 a, const f32x4 b) { u32x4 w; w.x = pk2(a[0], a[1]); w.y = pk2(a[2], a[3]); w.z = pk2(b[0], b[1]); w.w = pk2(b[2], b[3]); return __builtin_bit_cast(bf16x8, w); }
constexpr int DP_KS = 0, DP_VS = 33024, DP_QS = 66048, DP_KB = 99072, DP_QB = 117504, DP_MISC = 135936, DP_ATL = 137216, DP_AP = 68;
__device__ __forceinline__ void dn_chunk_prep(const Args& a, unsigned char* ws, int l, int unit, LAS unsigned char* lds, int tid) {
    const int lane = tid & 63, wave = __builtin_amdgcn_readfirstlane(tid >> 6), q4 = lane >> 4, fr = lane & 15;
    const bf16_t* proj = (const bf16_t*)(ws + WS_PROJ);
    const int bh = unit >> 6, n = unit & 63, b = bh / 6, h = bh % 6, t0 = n * 64; const size_t row0 = (size_t)b * SEQ + t0;
    LAS float* ks = (LAS float*)(lds + DP_KS); LAS float* vs = (LAS float*)(lds + DP_VS); LAS float* qs = (LAS float*)(lds + DP_QS);
    LAS unsigned char* kb = lds + DP_KB; LAS unsigned char* qb = lds + DP_QB; LAS float* gcs = (LAS float*)(lds + DP_MISC); LAS float* bes = gcs + 64; LAS float* egs = gcs + 128;
    bf16_t* WN = (bf16_t*)(ws + WS_DWN) + (size_t)unit * 8192; bf16_t* QD = (bf16_t*)(ws + WS_DQD) + (size_t)unit * 8192; bf16_t* KT = (bf16_t*)(ws + WS_DKT) + (size_t)unit * 8192;
    bf16_t* AT = (bf16_t*)(ws + WS_DAT) + (size_t)unit * 4096; float* UD = (float*)(ws + WS_DUD) + (size_t)unit * 8192; float* CD = (float*)(ws + WS_DCD);
    const float* cw = a.in[I_CONVW] + (size_t)l * 4 * 2304;
    __syncthreads();
    { const int d = tid & 127, c0 = 16 * (tid >> 7); float xin[3][19], wv[3][4];
#pragma unroll
      for (int w3 = 0; w3 < 3; ++w3) { const int chn = w3 * 768 + h * 128 + d;
#pragma unroll
          for (int i = 0; i < 4; ++i) wv[w3][i] = cw[i * 2304 + chn];
#pragma unroll
          for (int i = 0; i < 19; ++i) xin[w3][i] = (t0 + c0 - 3 + i >= 0) ? __uint_as_float((unsigned)proj[(row0 + c0 - 3 + i) * NINP + PC_DQKV + chn] << 16) : 0.f; }
#pragma unroll
      for (int w3 = 0; w3 < 3; ++w3) { LAS float* dst = w3 == 0 ? qs : (w3 == 1 ? ks : vs);
#pragma unroll
          for (int c = 0; c < 16; ++c) { const float acc = wv[w3][0] * xin[w3][c] + wv[w3][1] * xin[w3][c + 1] + wv[w3][2] * xin[w3][c + 2] + wv[w3][3] * xin[w3][c + 3];
              dst[(c0 + c) * 129 + d] = acc * __builtin_amdgcn_rcpf(1.0f + __builtin_amdgcn_exp2f(-1.44269504089f * acc)); } } }
    if (wave == 0) { const size_t row = row0 + lane; const float av = __uint_as_float((unsigned)proj[row * NINP + PC_DA + h] << 16), bv = __uint_as_float((unsigned)proj[row * NINP + PC_DB + h] << 16);
        const float x = av + a.in[I_DTB][l * 6 + h]; const float sp = fmaxf(x, 0.f) + log1pf(expf(-fabsf(x))); float g = -expf(a.in[I_ALOG][l * 6 + h]) * sp;
#pragma unroll
        for (int o = 1; o < 64; o <<= 1) { const float t = __int_as_float(__builtin_amdgcn_ds_bpermute(((lane - o) & 63) << 2, __float_as_int(g))); if (lane >= o) g += t; }
        gcs[lane] = g; bes[lane] = sigmoidf_(bv); egs[lane] = expf(g); if (lane == 63) CD[unit] = expf(g); }
    __syncthreads();
    { const int c = wave * 8 + (lane >> 3), sg = lane & 7; float qv[16], kv[16]; float sq = 0.f, sk = 0.f;
#pragma unroll
      for (int i = 0; i < 16; ++i) { qv[i] = qs[c * 129 + 16 * sg + i]; kv[i] = ks[c * 129 + 16 * sg + i]; sq += qv[i] * qv[i]; sk += kv[i] * kv[i]; }
#pragma unroll
      for (int o = 1; o < 8; o <<= 1) { sq += shx(lane, sq, o); sk += shx(lane, sk, o); }
      const float qsc = rsqrtf(sq + EPS) * 0.08838834764831845f, ksc = rsqrtf(sk + EPS);
#pragma unroll
      for (int i = 0; i < 16; ++i) { qv[i] *= qsc; kv[i] *= ksc; qs[c * 129 + 16 * sg + i] = qv[i]; ks[c * 129 + 16 * sg + i] = kv[i]; }
      u32x4 w0, w1; w0.x = pk2(qv[0], qv[1]); w0.y = pk2(qv[2], qv[3]); w0.z = pk2(qv[4], qv[5]); w0.w = pk2(qv[6], qv[7]); w1.x = pk2(qv[8], qv[9]); w1.y = pk2(qv[10], qv[11]); w1.z = pk2(qv[12], qv[13]); w1.w = pk2(qv[14], qv[15]);
      *(LAS u32x4*)(qb + c * 288 + sg * 32) = w0; *(LAS u32x4*)(qb + c * 288 + sg * 32 + 16) = w1;
      w0.x = pk2(kv[0], kv[1]); w0.y = pk2(kv[2], kv[3]); w0.z = pk2(kv[4], kv[5]); w0.w = pk2(kv[6], kv[7]); w1.x = pk2(kv[8], kv[9]); w1.y = pk2(kv[10], kv[11]); w1.z = pk2(kv[12], kv[13]); w1.w = pk2(kv[14], kv[15]);
      *(LAS u32x4*)(kb + c * 288 + sg * 32) = w0; *(LAS u32x4*)(kb + c * 288 + sg * 32 + 16) = w1; }
    __syncthreads();
    { const float gl = gcs[63];
      for (int it = 0; it < 16; ++it) { const int idx = it * NTHR + tid, c = idx >> 7, d = idx & 127;
          const int p = d, blk32 = p & ~31, pp = p & 31, qq = pp >> 3, jj = pp & 7, dk = blk32 + ((jj < 4) ? 4 * qq + jj : 16 + 4 * qq + (jj - 4));
          QD[c * 128 + p] = (bf16_t)(pk2(qs[c * 129 + dk] * egs[c], 0.f) & 0xffffu); }
      for (int it = 0; it < 16; ++it) { const int idx = it * NTHR + tid, dk = idx >> 6, p = idx & 63;
          const int blk32 = p & ~31, pp = p & 31, qq = pp >> 3, jj = pp & 7, c = blk32 + ((jj < 4) ? 4 * qq + jj : 16 + 4 * qq + (jj - 4));
          KT[dk * 64 + p] = (bf16_t)(pk2(ks[c * 129 + dk] * expf(gl - gcs[c]), 0.f) & 0xffffu); } }
    __syncthreads();
    LAS float* Am = qs;
    for (int job = wave; job < 32; job += NWAVES) { const int kind = job >> 4, ti = (job >> 2) & 3, tj = job & 3;
        f32x4 acc = {0.f, 0.f, 0.f, 0.f};
        if (ti >= tj) { const LAS unsigned char* ab = (kind ? qb : kb) + (16 * ti + fr) * 288 + q4 * 16; const LAS unsigned char* bb = kb + (16 * tj + fr) * 288 + q4 * 16;
#pragma unroll
            for (int k4 = 0; k4 < 4; ++k4) acc = __builtin_amdgcn_mfma_f32_16x16x32_bf16(*(const LAS bf16x8*)(ab + k4 * 64), *(const LAS bf16x8*)(bb + k4 * 64), acc, 0, 0, 0); }
        const int e = 16 * tj + fr; const float ge = gcs[e];
#pragma unroll
        for (int r = 0; r < 4; ++r) { const int c = 16 * ti + 4 * q4 + r; const float dec = expf(fminf(gcs[c] - ge, 0.f));
            if (kind == 0) { Am[c * DP_AP + e] = (c > e) ? bes[c] * acc[r] * dec : 0.f; }
            else { *(LAS bf16_t*)(lds + DP_ATL + c * 144 + kperm(e) * 2) = (bf16_t)(pk2((c >= e) ? acc[r] * dec : 0.f, 0.f) & 0xffffu); } } }
    __syncthreads();
    { const int c = tid >> 3, pc = tid & 7; *(u32x4*)(AT + c * 64 + pc * 8) = *(const LAS u32x4*)(lds + DP_ATL + c * 144 + pc * 16); }
    if (tid < 256) { const int col = tid & 127; const bool isw = tid >= 128; float x[64]; int zoff = 0; asm volatile("" : "+v"(zoff));
        const LAS float* Amv = Am + zoff;
#pragma unroll
        for (int c = 0; c < 64; ++c) x[c] = isw ? ks[c * 129 + col] * bes[c] * egs[c] : vs[c * 129 + col] * bes[c];
#pragma unroll
        for (int c = 1; c < 64; ++c) { float s0 = x[c], s1 = 0.f, s2 = 0.f, s3 = 0.f;
#pragma unroll
            for (int e4 = 0; e4 < (c + 3) / 4; ++e4) { const f32x4 av = *(const LAS f32x4*)(Amv + c * DP_AP + 4 * e4);
                if (4 * e4 + 0 < c) s0 -= av[0] * x[4 * e4 + 0]; if (4 * e4 + 1 < c) s1 -= av[1] * x[4 * e4 + 1];
                if (4 * e4 + 2 < c) s2 -= av[2] * x[4 * e4 + 2]; if (4 * e4 + 3 < c) s3 -= av[3] * x[4 * e4 + 3]; }
            x[c] = (s0 + s1) + (s2 + s3); }
        if (!isw) { const int s8 = col >> 4, f = col & 15;
#pragma unroll
            for (int mt = 0; mt < 4; ++mt)
#pragma unroll
                for (int qq = 0; qq < 4; ++qq) *(f32x4*)(UD + ((size_t)((s8 * 4 + mt) * 64 + qq * 16 + f)) * 4) = (f32x4){x[16 * mt + 4 * qq], x[16 * mt + 4 * qq + 1], x[16 * mt + 4 * qq + 2], x[16 * mt + 4 * qq + 3]}; }
        else { const int p = kperm(col);
#pragma unroll
            for (int c = 0; c < 64; ++c) *(LAS bf16_t*)(kb + c * 288 + p * 2) = (bf16_t)(pk2(-x[c], 0.f) & 0xffffu); } }
    __syncthreads();
#pragma unroll
    for (int i = 0; i < 2; ++i) { const int pi = tid + NTHR * i, c = pi >> 4, pc = pi & 15; *(u32x4*)(WN + c * 128 + pc * 8) = *(const LAS u32x4*)(kb + c * 288 + pc * 16); }
}
constexpr int DS2_WN = 0, DS2_KT = 18432, DS2_BYTES = 38912;
__device__ __forceinline__ void dn_scan_wg2(unsigned char* ws, int bh, int half, LAS unsigned char* lds, int tid) {
    const int lane = tid & 63, wv = __builtin_amdgcn_readfirstlane(tid >> 6), s8 = half * 4 + (wv & 3), q4 = lane >> 4, fr = lane & 15; const bool cw = wv < 4;
    const f32x4 z4 = {0.f, 0.f, 0.f, 0.f};
    f32x4 S[8]; bf16x8 Sb[4];
#pragma unroll
    for (int i = 0; i < 8; ++i) S[i] = z4;
#pragma unroll
    for (int i = 0; i < 4; ++i) Sb[i] = pack8(z4, z4);
    const int r16a = tid >> 4, pc16 = tid & 15, r8a = tid >> 3, pc8 = tid & 7;
    const unsigned char* gWN = ws + WS_DWN + (size_t)bh * 64 * 16384; const unsigned char* gKT = ws + WS_DKT + (size_t)bh * 64 * 16384;
    const f32x4* gUD = (const f32x4*)(ws + WS_DUD) + ((size_t)bh * 64 * 8 + s8) * 256 + lane;
    bf16x8* gSS = (bf16x8*)(ws + WS_DSS) + ((size_t)bh * 64 * 8 + s8) * 256 + lane; bf16x8* gVN = (bf16x8*)(ws + WS_DVN) + ((size_t)bh * 64 * 8 + s8) * 128 + lane;
    u32x4 st[4]; f32x4 udn[4]; float decn;
    const float* gCD = (const float*)(ws + WS_DCD) + bh * 64;
#define DN_LOAD2(n_) do { const size_t o16 = (size_t)(n_) * 16384; \
        st[0] = *(const u32x4*)(gWN + o16 + r16a * 256 + pc16 * 16); st[1] = *(const u32x4*)(gWN + o16 + (r16a + 32) * 256 + pc16 * 16); \
        st[2] = *(const u32x4*)(gKT + o16 + r8a * 128 + pc8 * 16); st[3] = *(const u32x4*)(gKT + o16 + (r8a + 64) * 128 + pc8 * 16); \
        decn = gCD[n_]; \
        if (cw) { _Pragma("unroll") for (int mt = 0; mt < 4; ++mt) udn[mt] = gUD[(size_t)(n_) * 2048 + mt * 64]; } } while (0)
    DN_LOAD2(0);
    const LAS unsigned char* aW = lds + DS2_WN + fr * 288 + q4 * 16; const LAS unsigned char* aK = lds + DS2_KT + fr * 160 + q4 * 16;
    for (int n = 0; n < 64; ++n) {
        __syncthreads();
        *(LAS u32x4*)(lds + DS2_WN + r16a * 288 + pc16 * 16) = st[0]; *(LAS u32x4*)(lds + DS2_WN + (r16a + 32) * 288 + pc16 * 16) = st[1];
        *(LAS u32x4*)(lds + DS2_KT + r8a * 160 + pc8 * 16) = st[2]; *(LAS u32x4*)(lds + DS2_KT + (r8a + 64) * 160 + pc8 * 16) = st[3];
        f32x4 vn[4];
#pragma unroll
        for (int mt = 0; mt < 4; ++mt) vn[mt] = udn[mt];
        const float dec = decn;
        if (cw) {
#pragma unroll
        for (int i = 0; i < 4; ++i) gSS[(size_t)n * 2048 + i * 64] = Sb[i]; }
        { const int nn = n + 1 < 64 ? n + 1 : 63; DN_LOAD2(nn); }
        __syncthreads();
        if (cw) {
        bf16x8 fw[16], fk[16];
#pragma unroll
        for (int i = 0; i < 16; ++i) fw[i] = *(const LAS bf16x8*)(aW + (i >> 2) * 16 * 288 + (i & 3) * 64);
        __builtin_amdgcn_sched_barrier(0);
#pragma unroll
        for (int k4 = 0; k4 < 4; ++k4)
#pragma unroll
            for (int mt = 0; mt < 4; ++mt) vn[mt] = __builtin_amdgcn_mfma_f32_16x16x32_bf16(fw[mt * 4 + k4], Sb[k4], vn[mt], 0, 0, 0);
        __builtin_amdgcn_sched_barrier(0);
#pragma unroll
        for (int i = 0; i < 16; ++i) fk[i] = *(const LAS bf16x8*)(aK + (i >> 1) * 16 * 160 + (i & 1) * 64);
#pragma unroll
        for (int t8 = 0; t8 < 8; ++t8) S[t8] = S[t8] * dec;
        bf16x8 Vb[2]; Vb[0] = pack8(vn[0], vn[1]); Vb[1] = pack8(vn[2], vn[3]);
        gVN[(size_t)n * 1024] = Vb[0]; gVN[(size_t)n * 1024 + 64] = Vb[1];
        __builtin_amdgcn_sched_barrier(0);
#pragma unroll
        for (int k2 = 0; k2 < 2; ++k2)
#pragma unroll
            for (int t8 = 0; t8 < 8; ++t8) S[t8] = __builtin_amdgcn_mfma_f32_16x16x32_bf16(fk[t8 * 2 + k2], Vb[k2], S[t8], 0, 0, 0);
#pragma unroll
        for (int i = 0; i < 4; ++i) Sb[i] = pack8(S[2 * i], S[2 * i + 1]);
        }
    }
#undef DN_LOAD2
    __syncthreads();
}
__device__ __forceinline__ void dn_out_unit(unsigned char* ws, int unit, int tid) {
    const int lane = tid & 63, s8 = __builtin_amdgcn_readfirstlane(tid >> 6), q4 = lane >> 4, fr = lane & 15;
    const int bh = unit >> 6, n = unit & 63, b = bh / 6, h = bh % 6;
    const bf16_t* qd = (const bf16_t*)(ws + WS_DQD) + (size_t)unit * 8192 + fr * 128 + q4 * 8; const bf16_t* at = (const bf16_t*)(ws + WS_DAT) + (size_t)unit * 4096 + fr * 64 + q4 * 8;
    const bf16x8* gSS = (const bf16x8*)(ws + WS_DSS) + ((size_t)unit * 8 + s8) * 256 + lane; const bf16x8* gVN = (const bf16x8*)(ws + WS_DVN) + ((size_t)unit * 8 + s8) * 128 + lane;
    bf16x8 Sb[4], Vb[2], fq[16], fa[8];
#pragma unroll
    for (int i = 0; i < 4; ++i) Sb[i] = gSS[i * 64];
    Vb[0] = gVN[0]; Vb[1] = gVN[64];
#pragma unroll
    for (int i = 0; i < 16; ++i) fq[i] = *(const bf16x8*)(qd + (i >> 2) * 2048 + (i & 3) * 32);
#pragma unroll
    for (int i = 0; i < 8; ++i) fa[i] = *(const bf16x8*)(at + (i >> 1) * 1024 + (i & 1) * 32);
    __builtin_amdgcn_sched_barrier(0);
    f32x4 o[4]; float* DO = (float*)(ws + WS_DO);
#pragma unroll
    for (int mt = 0; mt < 4; ++mt) o[mt] = (f32x4){0.f, 0.f, 0.f, 0.f};
#pragma unroll
    for (int k4 = 0; k4 < 4; ++k4)
#pragma unroll
        for (int mt = 0; mt < 4; ++mt) o[mt] = __builtin_amdgcn_mfma_f32_16x16x32_bf16(fq[mt * 4 + k4], Sb[k4], o[mt], 0, 0, 0);
#pragma unroll
    for (int k2 = 0; k2 < 2; ++k2)
#pragma unroll
        for (int mt = 0; mt < 4; ++mt) o[mt] = __builtin_amdgcn_mfma_f32_16x16x32_bf16(fa[mt * 2 + k2], Vb[k2], o[mt], 0, 0, 0);
#pragma unroll
    for (int mt = 0; mt < 4; ++mt) { float* orow = DO + ((size_t)b * SEQ + n * 64 + 16 * mt + 4 * q4) * 768 + h * 128 + 16 * s8 + fr;
#pragma unroll
        for (int r = 0; r < 4; ++r) orow[(size_t)r * 768] = o[mt][r]; }
}

typedef short s16x4 __attribute__((ext_vector_type(4)));
constexpr int A2_K = 0, A2_V = 73728, A2_BIAS = 147456, A2_P = 288;
__device__ __forceinline__ s16x4 tr_read(const LAS unsigned char* p) { return __builtin_bit_cast(s16x4, __builtin_amdgcn_ds_read_tr16_b64_v4i16((LAS s16x4*)p)); }
__device__ __forceinline__ void attn_unit_mfma(const Args& a, unsigned char* ws, int unit, LAS unsigned char* lds, int tid) {
    const int lane = tid & 63, w = __builtin_amdgcn_readfirstlane(tid >> 6), q4 = lane >> 4, fr = lane & 15;
    const bf16_t* proj = (const bf16_t*)(ws + WS_PROJ);
    const int gi = unit / 384, rem = unit % 384, b = rem / 192, h = (rem >> 5) % 6, idx = rem & 31;
    const int dl = gi == 0 ? 1 : (gi == 1 ? 4 : 16), r = idx % dl, qb = idx / dl, i0 = qb * 128;
    float* AO = (float*)(ws + WS_AO) + (size_t)gi * M * 768; float* ALSE = (float*)(ws + WS_ALSE) + (size_t)gi * M * 8;
    LAS unsigned char* Kl = lds + A2_K; LAS unsigned char* Vl = lds + A2_V; LAS float* biasT = (LAS float*)(lds + A2_BIAS);
    __syncthreads();
    for (int it = tid; it < 256 * 16; it += NTHR) { const int kk = it >> 4, c8 = it & 15, j = i0 - 128 + kk;
        u32x4 kw = {0u, 0u, 0u, 0u}, vw = {0u, 0u, 0u, 0u};
        if (j >= 0) { const size_t row = (size_t)b * SEQ + (size_t)j * dl + r; kw = *(const u32x4*)(proj + row * NINP + PC_AK + h * 128 + 8 * c8); vw = *(const u32x4*)(proj + row * NINP + PC_AV + h * 128 + 8 * c8); }
        *(LAS u32x4*)(Kl + kk * A2_P + c8 * 16) = kw; *(LAS u32x4*)(Vl + kk * A2_P + c8 * 16) = vw; }
    if (tid < 129) { const int dist = tid * dl; int bucket;
        if (dist < 16) bucket = dist; else { const float lg = 16.f + logf((float)dist / 16.f) / 4.852030263919617f * 16.f; bucket = (int)lg; bucket = bucket > 31 ? 31 : bucket; }
        biasT[tid] = a.in[I_RELB][bucket * 6 + h]; }
    const size_t qrow = (size_t)b * SEQ + (size_t)(i0 + 16 * w + fr) * dl + r;
    bf16x8 Qf[4];
    { const bf16_t* qp = proj + qrow * NINP + PC_AQ + h * 128 + 8 * q4;
#pragma unroll
      for (int ks = 0; ks < 4; ++ks) Qf[ks] = *(const bf16x8*)(qp + 32 * ks); }
    __syncthreads();
    f32x4 sc9[9]; float mx = -1e30f;
#pragma unroll
    for (int t = 0; t < 9; ++t) { f32x4 acc = {0.f, 0.f, 0.f, 0.f}; const LAS unsigned char* kr = Kl + (16 * (w + t) + fr) * A2_P + q4 * 16;
#pragma unroll
        for (int ks = 0; ks < 4; ++ks) acc = __builtin_amdgcn_mfma_f32_16x16x32_bf16(*(const LAS bf16x8*)(kr + ks * 64), Qf[ks], acc, 0, 0, 0);
#pragma unroll
        for (int e = 0; e < 4; ++e) { const int rel = 128 + fr - 16 * t - 4 * q4 - e, kl = 16 * (w + t) + 4 * q4 + e; const bool valid = (rel >= 0) && (rel <= 128) && (i0 - 128 + kl >= 0);
            const float s = valid ? acc[e] * 0.08838834764831845f + biasT[rel < 0 ? 0 : (rel > 128 ? 128 : rel)] : -1e30f; acc[e] = s; mx = fmaxf(mx, s); }
        sc9[t] = acc; }
    mx = fmaxf(mx, shx(lane, mx, 16)); mx = fmaxf(mx, shx(lane, mx, 32));
    float sum = 0.f;
#pragma unroll
    for (int t = 0; t < 9; ++t)
#pragma unroll
        for (int e = 0; e < 4; ++e) { const float p = __expf(sc9[t][e] - mx); sc9[t][e] = p; sum += p; }
    sum += shx(lane, sum, 16); sum += shx(lane, sum, 32);
    f32x4 o[8];
#pragma unroll
    for (int dt = 0; dt < 8; ++dt) o[dt] = (f32x4){0.f, 0.f, 0.f, 0.f};
    const f32x4 z4 = {0.f, 0.f, 0.f, 0.f};
#pragma unroll
    for (int s = 0; s < 5; ++s) { const bf16x8 Pf = pack8(sc9[2 * s], s < 4 ? sc9[2 * s + 1] : z4);
        const LAS unsigned char* v0 = Vl + (16 * w + 32 * s + 4 * q4 + (fr >> 2)) * A2_P + 8 * (fr & 3); const LAS unsigned char* v1 = s < 4 ? v0 + 16 * A2_P : v0;
#pragma unroll
        for (int dt = 0; dt < 8; ++dt) { const s16x4 lo = tr_read(v0 + dt * 32), hi = tr_read(v1 + dt * 32);
            const bf16x8 Vf = {lo[0], lo[1], lo[2], lo[3], hi[0], hi[1], hi[2], hi[3]};
            o[dt] = __builtin_amdgcn_mfma_f32_16x16x32_bf16(Vf, Pf, o[dt], 0, 0, 0); } }
    const float inv = 1.f / sum;
    float* orow = AO + qrow * 768 + h * 128 + 4 * q4;
#pragma unroll
    for (int dt = 0; dt < 8; ++dt) *(f32x4*)(orow + 16 * dt) = o[dt] * inv;
    if (q4 == 0) ALSE[qrow * 8 + h] = mx + logf(sum);
}

constexpr int PH_PER_LAYER = 13, NPH = 1 + PH_PER_LAYER * DEPTH;
__global__ void __launch_bounds__(NTHR, 2) fwd_kernel(Args args) {
    extern __shared__ __attribute__((aligned(16))) unsigned char lds_raw[];
    LAS unsigned char* lds = (LAS unsigned char*)lds_raw;
    volatile LAS unsigned* MISC = (volatile LAS unsigned*)(lds + MISC_OFF);
    const int tid = threadIdx.x;
    const int G = gridDim.x, blk = blockIdx.x;
    const int lo = args.ph_lo, hi = args.ph_hi;
    unsigned char* ws = args.ws;
    if (tid < 64) MISC[tid] = 0u;
    __syncthreads();
    XcdBarrier bar; bar.bar = (unsigned*)(ws + WS_CTL) + CW_BAR; bar.x = 0; bar.st = nullptr;
    if (hi - lo > 1) bar = xcd_barrier_post((unsigned*)(ws + WS_CTL) + CW_BAR, MISC + 8);
#define IN(k) (lo <= (k) && (k) < hi)
#define FRESH() int tidl = tid; unsigned wz_ = 0; asm volatile("" : "+v"(tidl), "+s"(wz_)); unsigned char* wsl = ws + wz_
#define SEAM(k) do { if (IN(k) && IN((k) + 1)) xcd_barrier(bar); } while (0)

    if (IN(0)) { FRESH(); p0_prologue(args, wsl, lds, blk, G, tidl); }
    SEAM(0);
    for (int l = 0; l < DEPTH; ++l) {
        const int pb = 1 + PH_PER_LAYER * l;
        const float* gains = args.in[I_GAINS] + (size_t)l * 6 * D;
#pragma unroll
        for (int f = 0; f < 2; ++f) {
            const int p0 = pb + (f ? 10 : 0);
            if (IN(p0)) {
                FRESH(); pg8::Gemm g{(const bf16_t*)(wsl + WS_H), (const bf16_t*)(wsl + WS_WGU) + (size_t)(l * 2 + f) * NGU * D, M, NGU, D};
                pg8::EpiSwiGLU E{(bf16_t*)(wsl + WS_ACT), DFF};
                GemmOrder S; S.init(M, NGU, G, blk); pg8::gemm_phase<pg8::EpiSwiGLU, GemmOrder, true, true>(lds, g, S, E, tidl);
                conv_slot(args, wsl, l + 1, l * 3 + f, (unsigned)G, lds, MISC, tidl);
            }
            SEAM(p0);
            if (IN(p0 + 1)) {
                FRESH(); pg8::Gemm g{(const bf16_t*)(wsl + WS_ACT), (const bf16_t*)(wsl + WS_WD) + (size_t)(l * 2 + f) * D * DFF, M, D, DFF}; GemmOrder S; S.init(M, D, G, blk);
                pg8::EpiBf16P E{(bf16_t*)(wsl + WS_Y), D};
                pg8::gemm_phase<pg8::EpiBf16P, GemmOrder, true, true>(lds, g, S, E, tidl);
            }
            SEAM(p0 + 1);
            if (IN(p0 + 2)) {
                const bool last = (f == 1 && l == DEPTH - 1);
                if (f == 1) { FRESH(); conv_slot(args, wsl, l + 1, 15, 0u, lds, MISC, tidl); }
                FRESH(); bf16_t* X = (bf16_t*)(wsl + WS_X); const bf16_t* Yb = (const bf16_t*)(wsl + WS_Y); bf16_t* Hb = (bf16_t*)(wsl + WS_H);
                const float* gpre = f == 0 ? gains + 2 * D : (last ? gains : args.in[I_GAINS] + (size_t)(l + 1) * 6 * D); const float* gpost = gains + (f ? 5 : 1) * D;
                if (f == 0 && l == 0) thin_phase<true, false>(args.in[I_X], X, Yb, gpost, 0.5f, gpre, Hb, blk, G, tidl);
                else if (last) thin_phase<false, true>(X, args.out, Yb, gpost, 0.5f, gpre, (bf16_t*)nullptr, blk, G, tidl);
                else thin_phase<false, false>(X, X, Yb, gpost, 0.5f, gpre, Hb, blk, G, tidl);
            }
            SEAM(p0 + 2);
            if (f == 1) break;
            if (IN(pb + 3)) {
                FRESH(); pg8::Gemm g{(const bf16_t*)(wsl + WS_H), (const bf16_t*)(wsl + WS_WIN) + (size_t)l * NINP * D, M, NINP, D}; GemmOrder S; S.init(M, NINP, G, blk);
                pg8::EpiBf16P E{(bf16_t*)(wsl + WS_PROJ), NINP};
                pg8::gemm_phase<pg8::EpiBf16P, GemmOrder, true, true>(lds, g, S, E, tidl);
            }
            SEAM(pb + 3);
            if (IN(pb + 4)) { FRESH();
                ssm_local(args, wsl, l, blk, G, tidl, lds);
                for (int u = blk; u < 768; u += G) dn_chunk_prep(args, wsl, l, u, lds, tidl); }
            SEAM(pb + 4);
            if (IN(pb + 5)) {
                FRESH(); const int lane = tidl & 63, wave = __builtin_amdgcn_readfirstlane(tidl >> 6), gw = blk * NWAVES + wave, ngw = G * NWAVES;
                if (blk < 24) { dn_scan_wg2(wsl, blk >> 1, blk & 1, lds, tidl); }
                if (blk >= 24) for (int wu = (blk - 24) * NWAVES + wave; wu < 4096; wu += (G - 24) * NWAVES) ssm_final_unit(args, wsl, l, wu, lds + wave * SSM_WLDS, lane);
                __syncthreads();
                if (blk >= 24) for (int u = blk - 24; u < 1152; u += G - 24) attn_unit_mfma(args, wsl, u, lds, tidl);
                conv_slot(args, wsl, l + 1, l * 3 + 2, (unsigned)G, lds, MISC, tidl);
            }
            SEAM(pb + 5);
            if (IN(pb + 6)) {
                if (blk >= 64) { FRESH(); for (int u = blk - 64; u < 768; u += G - 64) dn_out_unit(wsl, u, tidl); }
                FRESH(); pg8::Gemm g{(const bf16_t*)(wsl + WS_YGB), (const bf16_t*)(wsl + WS_WGLU) + (size_t)l * 512 * 512, M, 512, 512}; GemmOrder S; S.init(M, 512, G, blk);
                pg8::EpiF32 E{(float*)(wsl + WS_Z), 512};
                pg8::gemm_phase<pg8::EpiF32, GemmOrder, true, true>(lds, g, S, E, tidl);
            }
            SEAM(pb + 6);
            if (IN(pb + 7)) { FRESH(); mix_phase(args, wsl, l, blk, G, tidl);
            }
            SEAM(pb + 7);
            if (IN(pb + 8)) {
                FRESH(); pg8::Gemm g{(const bf16_t*)(wsl + WS_MIX), (const bf16_t*)(wsl + WS_WOUT) + (size_t)l * D * D, M, D, D}; GemmOrder S; S.init(M, D, G, blk);
                pg8::EpiBf16P E{(bf16_t*)(wsl + WS_Y), D};
                pg8::gemm_phase<pg8::EpiBf16P, GemmOrder, true, true>(lds, g, S, E, tidl);
            }
            SEAM(pb + 8);
            if (IN(pb + 9)) { FRESH(); bf16_t* X = (bf16_t*)(wsl + WS_X); thin_phase<false, false>(X, X, (const bf16_t*)(wsl + WS_Y), gains + 3 * D, 1.0f, gains + 4 * D, (bf16_t*)(wsl + WS_H), blk, G, tidl); }
            SEAM(pb + 9);
        }
    }
#undef IN
#undef SEAM
}

#ifndef MK_ONE_LAUNCH
#define MK_ONE_LAUNCH 1
#endif
extern "C" void kernel_launch(void* const* d_in, const int* in_sizes, int n_in, void* d_out, int out_size, void* d_ws, size_t ws_size, hipStream_t stream) {
    static int grid = 0;
    if (grid == 0) {
        if (n_in != N_IN || in_sizes[0] != M * D || out_size != M * D || ws_size < WS_END) { fprintf(stderr, "kernel_launch: unexpected shapes (n_in %d, in0 %d, out %d, ws %zu, need %zu)\n", n_in, n_in > 0 ? in_sizes[0] : -1, out_size, ws_size, (size_t)WS_END); grid = -1; return; }
        int dev = 0, cus = 0, per_cu = 0;
        if (hipGetDevice(&dev) != hipSuccess || hipDeviceGetAttribute(&cus, hipDeviceAttributeMultiprocessorCount, dev) != hipSuccess) { grid = -1; return; }
        if (hipFuncSetAttribute((const void*)fwd_kernel, hipFuncAttributeMaxDynamicSharedMemorySize, LDS_BYTES) != hipSuccess) { fprintf(stderr, "kernel_launch: hipFuncSetAttribute failed\n"); grid = -1; return; }
        if (hipOccupancyMaxActiveBlocksPerMultiprocessor(&per_cu, (const void*)fwd_kernel, NTHR, LDS_BYTES) != hipSuccess || per_cu < 1) fprintf(stderr, "kernel_launch: occupancy query reports %d\n", per_cu);
        (void)hipGetLastError();
        if (cus != 256) { fprintf(stderr, "kernel_launch: built for a 256-CU device (got %d)\n", cus); grid = -1; return; }
        grid = cus;
    }
    if (grid < 0) return;
    (void)hipMemsetAsync((char*)d_ws + WS_CTL, 0, CTL_ZERO_BYTES, stream);
    Args a{};
    for (int i = 0; i < N_IN; ++i) a.in[i] = (const float*)d_in[i];
    a.out = (float*)d_out; a.ws = (unsigned char*)d_ws;
#if MK_ONE_LAUNCH
    a.ph_lo = 0; a.ph_hi = NPH;
    hipLaunchKernelGGL(fwd_kernel, dim3(grid), dim3(NTHR), LDS_BYTES, stream, a);
#else
    for (int p = 0; p < NPH; ++p) { a.ph_lo = p; a.ph_hi = p + 1; hipLaunchKernelGGL(fwd_kernel, dim3(grid), dim3(NTHR), LDS_BYTES, stream, a); }
#endif
}
```

```cpp
#include <hip/hip_runtime.h>
#include <cstdio>
#include <cstdint>
namespace pg8 {
#define PG8_LAS __attribute__((address_space(3)))
typedef unsigned short bf16_t;
typedef short bf16x8 __attribute__((ext_vector_type(8)));
typedef float f32x4 __attribute__((ext_vector_type(4)));
typedef unsigned u32x4 __attribute__((ext_vector_type(4)));
constexpr int BM = 256, BK = 64, HALF = 128, HTB = HALF * BK * 2  , STAGE_BYTES = 8 * HTB, NXCD = 8, WGM = 8;

__host__ __device__ __forceinline__ int lds_byte(int r, int c) { const int st = (r >> 4) * 2 + (c >> 5), rr = r & 15, cc = c & 31, ob = rr * 64 + cc * 2; return st * 1024 + (ob ^ (((ob >> 9) & 1) << 5)); }
__host__ __device__ __forceinline__ void stage_rc(int b, int& R, int& C) { const int st = b / 1024, sb = b % 1024, swz = sb ^ (((sb >> 9) & 1) << 5); R = (st >> 1) * 16 + swz / 64; C = (st & 1) * 32 + (swz % 64) / 2; }
__host__ __device__ __forceinline__ int perm32(int rho) { const int n = rho >> 4, i = rho & 15; return 8 * (i >> 2) + 4 * n + (i & 3); }

struct Unit { int pm, pn; };
struct Gemm { const bf16_t* A; const bf16_t* Bt; int M, N, K; };

struct StaticOrder {
    int nM, nN, nwg, G, c;
    __host__ __device__ void init(int M, int N, int G_, int c_) { nM = M / BM; nN = N / BM; nwg = nM * nN; G = G_; c = c_; }
    __host__ __device__ bool next(int i, Unit& u) const {
        const long L = (long)i * G + c; if (L >= nwg) return false;
        int wgid = (int)L; { const int q = nwg / NXCD, r = nwg % NXCD, xcd = wgid % NXCD, off = wgid / NXCD; wgid = (xcd < r ? xcd * (q + 1) : r * (q + 1) + (xcd - r) * q) + off; }
        const int nig = WGM * nN, gid = wgid / nig, fm = gid * WGM, gsz = (nM - fm) < WGM ? (nM - fm) : WGM;
        u.pm = fm + ((wgid % nig) % gsz); u.pn = (wgid % nig) / gsz; return true;
    }
    __device__ __forceinline__ void a_ready(const Unit&) const {}
    __device__ __forceinline__ void done(const Unit&) const {}
};

typedef float f32x2c __attribute__((ext_vector_type(2))); typedef __bf16 bf16x2c __attribute__((ext_vector_type(2)));
__device__ __forceinline__ unsigned cvt_pk_bf16(float lo, float hi) { const f32x2c v = {lo, hi}; return __builtin_bit_cast(unsigned, __builtin_convertvector(v, bf16x2c)); }
struct EpiF32 {
    static constexpr bool PERM = false, AFTER_DRAIN = false;
    float* C; int ldc;
    __device__ __forceinline__ void operator()(const f32x4 (&acc)[2][2][4][2], const Unit& u, int wr, int wc, int fr, int fq) const {
        const int row0 = u.pm * BM + wr * 64 + fr, col0 = u.pn * BM + wc * 32 + 4 * fq;
#pragma unroll
        for (int ai = 0; ai < 2; ++ai)
#pragma unroll
            for (int m = 0; m < 4; ++m) { float* rowp = C + (size_t)(row0 + ai * HALF + m * 16) * ldc + col0;
#pragma unroll
                for (int bj = 0; bj < 2; ++bj)
#pragma unroll
                    for (int n = 0; n < 2; ++n) *(f32x4*)(rowp + bj * HALF + n * 16) = acc[ai][bj][m][n]; }
    }
};
struct EpiBf16P {
    static constexpr bool PERM = true, AFTER_DRAIN = false;
    bf16_t* O; int ldc;
    __device__ __forceinline__ void operator()(const f32x4 (&acc)[2][2][4][2], const Unit& u, int wr, int wc, int fr, int fq) const {
        const int row0 = u.pm * BM + wr * 64 + fr, col0 = u.pn * BM + wc * 32 + 8 * fq;
#pragma unroll
        for (int ai = 0; ai < 2; ++ai)
#pragma unroll
            for (int m = 0; m < 4; ++m) { bf16_t* rowp = O + (size_t)(row0 + ai * HALF + m * 16) * ldc + col0;
#pragma unroll
                for (int bj = 0; bj < 2; ++bj) { const f32x4 v0 = acc[ai][bj][m][0], v1 = acc[ai][bj][m][1];
                    u32x4 w; w.x = cvt_pk_bf16(v0[0], v0[1]); w.y = cvt_pk_bf16(v0[2], v0[3]); w.z = cvt_pk_bf16(v1[0], v1[1]); w.w = cvt_pk_bf16(v1[2], v1[3]);
                    *(u32x4*)(rowp + bj * HALF) = w; } }
    }
};
struct EpiSwiGLU {
    static constexpr bool PERM = true, AFTER_DRAIN = false;
    bf16_t* O; int ldc;
    __device__ __forceinline__ static float silu_mul(float g, float u) { return g * u * __builtin_amdgcn_rcpf(1.0f + __builtin_amdgcn_exp2f(-1.44269504089f * g)); }
    __device__ __forceinline__ void operator()(const f32x4 (&acc)[2][2][4][2], const Unit& u, int wr, int wc, int fr, int fq) const {
        const int row0 = u.pm * BM + wr * 64 + fr, col0 = u.pn * HALF + wc * 32 + 8 * fq;
#pragma unroll
        for (int ai = 0; ai < 2; ++ai)
#pragma unroll
            for (int m = 0; m < 4; ++m) { bf16_t* rowp = O + (size_t)(row0 + ai * HALF + m * 16) * ldc + col0;
                const f32x4 g0 = acc[ai][0][m][0], g1 = acc[ai][0][m][1], u0 = acc[ai][1][m][0], u1 = acc[ai][1][m][1];
                u32x4 w; w.x = cvt_pk_bf16(silu_mul(g0[0], u0[0]), silu_mul(g0[1], u0[1])); w.y = cvt_pk_bf16(silu_mul(g0[2], u0[2]), silu_mul(g0[3], u0[3]));
                w.z = cvt_pk_bf16(silu_mul(g1[0], u1[0]), silu_mul(g1[1], u1[1])); w.w = cvt_pk_bf16(silu_mul(g1[2], u1[2]), silu_mul(g1[3], u1[3]));
                *(u32x4*)rowp = w; }
    }
};

template <class Epi, class Sched, bool ALIGN_EPI = false, bool SP2 = false>
__device__ __forceinline__ void gemm_phase(PG8_LAS unsigned char* lds, const Gemm g, const Sched& S, const Epi& E, int tid_in) {
    const int tid = tid_in, wid = __builtin_amdgcn_readfirstlane(tid >> 6), lane = tid & 63, wr = wid >> 2, wc = wid & 3, fr = lane & 15, fq = lane >> 4;
    const int K = g.K, nt = K / BK;
    unsigned voffA[2], voffB[2];
#pragma unroll
    for (int i = 0; i < 2; ++i) { int R, C; stage_rc(tid * 16 + i * 8192, R, C); const int Rb = Epi::PERM ? ((R & ~31) + perm32(R & 31)) : R;
        voffA[i] = (unsigned)(R * K + C) * 2u; voffB[i] = (unsigned)(Rb * K + C) * 2u; }
    const size_t kstep = (size_t)(BK * 2);
    const size_t hstep = (size_t)HALF * K * 2;
    const size_t tstep = 2 * hstep;
    const unsigned ldsw = (unsigned)wid * 1024u;
    const int aoff = lds_byte(wr * 64 + fr, fq * 8), boff = lds_byte(wc * 32 + fr, fq * 8);
#define PG8_SA(b, h) (((b) * 2 + (h)) * HTB)
#define PG8_SB(b, h) ((4 + (b) * 2 + (h)) * HTB)
#define PG8_STAGE(bufoff, gbase, voff) do { _Pragma("unroll") for (int _i = 0; _i < 2; ++_i) \
        __builtin_amdgcn_global_load_lds((const unsigned*)((const char*)(gbase) + (voff)[_i]), (PG8_LAS unsigned*)(lds + (bufoff) + ldsw + _i * 8192), 16, 0, 0); } while (0)
#define PG8_LDA(dst, b, h) do { _Pragma("unroll") for (int m = 0; m < 4; ++m) _Pragma("unroll") for (int k = 0; k < 2; ++k) dst[m][k] = *(const PG8_LAS bf16x8*)(lds + PG8_SA(b, h) + aoff + m * 2048 + k * 1024); } while (0)
#define PG8_LDB(dst, b, h) do { _Pragma("unroll") for (int n = 0; n < 2; ++n) _Pragma("unroll") for (int k = 0; k < 2; ++k) dst[n][k] = *(const PG8_LAS bf16x8*)(lds + PG8_SB(b, h) + boff + n * 2048 + k * 1024); } while (0)
#define PG8_MMA(ai, bj, At, Bt) do { __builtin_amdgcn_s_setprio(1); _Pragma("unroll") for (int m = 0; m < 4; ++m) _Pragma("unroll") for (int n = 0; n < 2; ++n) _Pragma("unroll") for (int k = 0; k < 2; ++k) \
        acc[ai][bj][m][n] = __builtin_amdgcn_mfma_f32_16x16x32_bf16(Bt[n][k], At[m][k], acc[ai][bj][m][n], 0, 0, 0); __builtin_amdgcn_s_setprio(0); } while (0)
#define PG8_WAIT_V(n) asm volatile("s_waitcnt vmcnt(" #n ")" ::: "memory")
#define PG8_WAIT_L(n) asm volatile("s_waitcnt lgkmcnt(" #n ")" ::: "memory")
#define PG8_BAR __builtin_amdgcn_s_barrier()
#define PG8_SCHED __builtin_amdgcn_sched_barrier(0)
    Unit cur, nxt; int ui = 0;
    if (!S.next(0, cur)) return;
    f32x4 acc[2][2][4][2];
#pragma unroll
    for (int a = 0; a < 2; ++a)
#pragma unroll
        for (int b = 0; b < 2; ++b)
#pragma unroll
            for (int m = 0; m < 4; ++m)
#pragma unroll
                for (int n = 0; n < 2; ++n) acc[a][b][m][n] = (f32x4){0.f, 0.f, 0.f, 0.f};
    bf16x8 At[4][2], B0[2][2], B1[2][2];
    const char* cA = (const char*)g.A + (size_t)cur.pm * tstep; const char* cB = (const char*)g.Bt + (size_t)cur.pn * tstep;
    S.a_ready(cur);
    if constexpr (SP2) {
        PG8_STAGE(PG8_SB(0, 0), cB, voffB); PG8_STAGE(PG8_SB(0, 1), cB + hstep, voffB); PG8_STAGE(PG8_SA(0, 0), cA, voffA); PG8_STAGE(PG8_SA(0, 1), cA + hstep, voffA);
        if (wr == 1) PG8_BAR;
        PG8_WAIT_V(2); PG8_BAR;
        PG8_STAGE(PG8_SB(1, 0), cB + kstep, voffB); PG8_STAGE(PG8_SA(1, 0), cA + kstep, voffA); PG8_STAGE(PG8_SB(1, 1), cB + hstep + kstep, voffB);
        PG8_WAIT_V(6); PG8_BAR;
    } else {
        PG8_STAGE(PG8_SB(0, 0), cB, voffB); PG8_STAGE(PG8_SA(0, 0), cA, voffA); PG8_STAGE(PG8_SB(0, 1), cB + hstep, voffB); PG8_STAGE(PG8_SA(0, 1), cA + hstep, voffA);
        if (wr == 1) PG8_BAR;
        PG8_WAIT_V(4); PG8_BAR;
        PG8_STAGE(PG8_SB(1, 0), cB + kstep, voffB); PG8_STAGE(PG8_SA(1, 0), cA + kstep, voffA); PG8_STAGE(PG8_SB(1, 1), cB + hstep + kstep, voffB);
        PG8_WAIT_V(6); PG8_BAR;
    }
    for (;;) {
        const bool has_next = S.next(ui + 1, nxt);
        const char* nA = has_next ? (const char*)g.A + (size_t)nxt.pm * tstep : cA; const char* nB = has_next ? (const char*)g.Bt + (size_t)nxt.pn * tstep : cB;
        for (int t = 0; t < nt; t += 2) {
            const bool last = (t == nt - 2);
            const char* a1 = cA + (size_t)(t + 1) * kstep;
            const char* a2 = last ? nA : cA + (size_t)(t + 2) * kstep; const char* b2 = last ? nB : cB + (size_t)(t + 2) * kstep;
            const char* a3 = a2 + kstep; const char* b3 = b2 + kstep;
            if (last && has_next) S.a_ready(nxt);
            if constexpr (SP2) {
            PG8_LDB(B0, 0, 0); PG8_LDB(B1, 0, 1); PG8_SCHED; PG8_LDA(At, 0, 0); PG8_STAGE(PG8_SA(1, 1), a1 + hstep, voffA);
            PG8_WAIT_V(8); PG8_WAIT_L(0); PG8_BAR; PG8_MMA(0, 0, At, B0); PG8_MMA(0, 1, At, B1); PG8_BAR; PG8_SCHED;
            PG8_LDA(At, 0, 1); PG8_STAGE(PG8_SB(0, 0), b2, voffB); PG8_STAGE(PG8_SB(0, 1), b2 + hstep, voffB); PG8_STAGE(PG8_SA(0, 0), a2, voffA);
            PG8_WAIT_V(8); PG8_WAIT_L(0); PG8_BAR; PG8_MMA(1, 0, At, B0); PG8_MMA(1, 1, At, B1); PG8_BAR; PG8_SCHED;
            PG8_LDB(B0, 1, 0); PG8_LDB(B1, 1, 1); PG8_SCHED; PG8_LDA(At, 1, 0); PG8_STAGE(PG8_SA(0, 1), a2 + hstep, voffA);
            PG8_WAIT_V(8); PG8_WAIT_L(0); PG8_BAR; PG8_MMA(0, 0, At, B0); PG8_MMA(0, 1, At, B1); PG8_BAR; PG8_SCHED;
            PG8_LDA(At, 1, 1); PG8_STAGE(PG8_SB(1, 0), b3, voffB); PG8_STAGE(PG8_SB(1, 1), b3 + hstep, voffB); PG8_STAGE(PG8_SA(1, 0), a3, voffA);
            PG8_WAIT_V(8); PG8_WAIT_L(0); PG8_BAR; PG8_MMA(1, 0, At, B0); PG8_MMA(1, 1, At, B1); PG8_BAR; PG8_SCHED;
            } else {
            PG8_LDB(B0, 0, 0); PG8_SCHED; PG8_LDA(At, 0, 0); PG8_STAGE(PG8_SA(1, 1), a1 + hstep, voffA);
            PG8_WAIT_L(8); PG8_BAR; PG8_WAIT_L(0); PG8_MMA(0, 0, At, B0); PG8_BAR; PG8_SCHED;
            PG8_LDB(B1, 0, 1); PG8_STAGE(PG8_SB(0, 0), b2, voffB);
            PG8_BAR; PG8_WAIT_L(0); PG8_MMA(0, 1, At, B1); PG8_BAR;
            PG8_LDA(At, 0, 1); PG8_STAGE(PG8_SA(0, 0), a2, voffA);
            PG8_BAR; PG8_WAIT_L(0); PG8_MMA(1, 0, At, B0); PG8_BAR; PG8_SCHED;
            PG8_STAGE(PG8_SB(0, 1), b2 + hstep, voffB);
            PG8_WAIT_V(6); PG8_BAR; PG8_MMA(1, 1, At, B1); PG8_BAR;
            PG8_LDB(B0, 1, 0); PG8_SCHED; PG8_LDA(At, 1, 0); PG8_STAGE(PG8_SA(0, 1), a2 + hstep, voffA);
            PG8_WAIT_L(8); PG8_BAR; PG8_WAIT_L(0); PG8_MMA(0, 0, At, B0); PG8_BAR; PG8_SCHED;
            PG8_LDB(B1, 1, 1); PG8_STAGE(PG8_SB(1, 0), b3, voffB);
            PG8_BAR; PG8_WAIT_L(0); PG8_MMA(0, 1, At, B1); PG8_BAR;
            PG8_LDA(At, 1, 1); PG8_STAGE(PG8_SA(1, 0), a3, voffA);
            PG8_BAR; PG8_WAIT_L(0); PG8_MMA(1, 0, At, B0); PG8_BAR; PG8_SCHED;
            PG8_STAGE(PG8_SB(1, 1), b3 + hstep, voffB);
            PG8_WAIT_V(6); PG8_BAR; PG8_MMA(1, 1, At, B1); PG8_BAR;
            }
        }
        if constexpr (ALIGN_EPI) { if (wr == 0) PG8_BAR; }
        if constexpr (!Epi::AFTER_DRAIN) { E(acc, cur, wr, wc, fr, fq); S.done(cur); }
        if (!has_next) break;
#pragma unroll
        for (int a = 0; a < 2; ++a)
#pragma unroll
            for (int b = 0; b < 2; ++b)
#pragma unroll
                for (int m = 0; m < 4; ++m)
#pragma unroll
                    for (int n = 0; n < 2; ++n) acc[a][b][m][n] = (f32x4){0.f, 0.f, 0.f, 0.f};
        cur = nxt; cA = nA; cB = nB; ++ui;
        if constexpr (ALIGN_EPI) { if (wr == 1) PG8_BAR; }
    }
    PG8_WAIT_V(0);
    if constexpr (!ALIGN_EPI) { if (wr == 0) PG8_BAR; }
    PG8_BAR;
    if constexpr (Epi::AFTER_DRAIN) { E.fused(acc, cur, wr, wc, fr, fq, lds, wid, lane); S.done(cur); }
#undef PG8_SA
#undef PG8_SB
#undef PG8_STAGE
#undef PG8_LDA
#undef PG8_LDB
#undef PG8_MMA
#undef PG8_WAIT_V
#undef PG8_WAIT_L
#undef PG8_BAR
#undef PG8_SCHED
}
}

#define LAS __attribute__((address_space(3)))
typedef unsigned short bf16_t;
typedef float f32x4 __attribute__((ext_vector_type(4)));
typedef float f32x2 __attribute__((ext_vector_type(2)));
typedef unsigned u32x4 __attribute__((ext_vector_type(4)));
typedef unsigned u32x2 __attribute__((ext_vector_type(2)));
constexpr int NWAVES = 8, NTHR = 512;
constexpr int D = 2048, SEQ = 4096, M = 8192, DEPTH = 4, DFF = 5632, NGU = 2 * DFF, NIN = 5900, NINP = 6144;
constexpr int PC_SSM = 0, PC_AQ = 512, PC_AK = 1280, PC_AV = 2048, PC_DQKV = 2816, PC_DZ = 5120, PC_DA = 5888, PC_DB = 5894;
constexpr float EPS = 1e-6f;
enum { I_X = 0, I_GAINS, I_WG, I_WU, I_WD, I_WIN, I_WOUT, I_LRE, I_LIM, I_BRE, I_BIM, I_CRE, I_CIM, I_SD, I_LOGDT, I_GLUW, I_GLUB, I_SGAIN, I_CONVW, I_ALOG, I_DTB, I_DNG, I_ATG, I_RELB, N_IN };
constexpr size_t MiB = 1ull << 20;
constexpr size_t WS_CTL = 0, CTL_ZERO_BYTES = 1 * MiB;
constexpr size_t WS_WGU = 1 * MiB;
constexpr size_t WS_WD = WS_WGU + 352 * MiB;
constexpr size_t WS_WIN = WS_WD + 176 * MiB;
constexpr size_t WS_WOUT = WS_WIN + 96 * MiB;
constexpr size_t WS_WGLU = WS_WOUT + 32 * MiB;
constexpr size_t WS_X = WS_WGLU + 2 * MiB;
constexpr size_t WS_H = WS_X + 64 * MiB;
constexpr size_t WS_ACT = WS_H + 32 * MiB;
constexpr size_t WS_Y = WS_ACT + 88 * MiB;
constexpr size_t WS_PROJ = WS_Y + 64 * MiB;
constexpr size_t WS_MIX = WS_PROJ + 192 * MiB;
constexpr size_t WS_SSME = WS_MIX + 32 * MiB;
constexpr size_t WS_YG = WS_SSME + 2 * MiB;
constexpr size_t WS_YGB = WS_YG + 16 * MiB;
constexpr size_t WS_Z = WS_YGB + 8 * MiB;
constexpr size_t WS_DQ = WS_Z + 16 * MiB;
constexpr size_t WS_DK = WS_DQ + 24 * MiB;
constexpr size_t WS_DV = WS_DK + 24 * MiB;
constexpr size_t WS_DO = WS_DV + 24 * MiB;
constexpr size_t WS_DBG = WS_DO + 24 * MiB;
constexpr size_t WS_DWN = WS_DQ;
constexpr size_t WS_DQD = WS_DWN + 12 * MiB;
constexpr size_t WS_DKT = WS_DQD + 12 * MiB;
constexpr size_t WS_DAT = WS_DKT + 12 * MiB;
constexpr size_t WS_DUD = WS_DAT + 6 * MiB;
constexpr size_t WS_DCD = WS_DUD + 24 * MiB;
static_assert(WS_DCD + 1 * MiB <= WS_DO, "DN overlay");
constexpr size_t WS_AO = WS_DBG + 1 * MiB;
constexpr size_t WS_ALSE = WS_AO + 72 * MiB;
constexpr size_t WS_DSS = WS_ALSE + 1 * MiB;
constexpr size_t WS_DVN = WS_DSS + 24 * MiB;
constexpr size_t WS_END = WS_DVN + 12 * MiB;
constexpr int CW_BAR = 4096;
constexpr int LDS_BYTES = 155648, MISC_OFF = LDS_BYTES - 256;

#define XB_TMO      128
#define XB_XCNT(j)  (256  + 64 * (j))
#define XB_XSUB(j)  (1280 + 64 * (j))
#define XB_XGEN(j)  (2304 + 64 * (j))
#define XB_TOP      3328
#define XB_TOPGEN   3392
#define XCD_BAR_WORDS 3456
#define XB_SPIN_CAP (1u << 18)

__device__ __forceinline__ unsigned xb_ld(unsigned* p)              { return __hip_atomic_load(p, __ATOMIC_RELAXED, __HIP_MEMORY_SCOPE_AGENT); }
__device__ __forceinline__ unsigned xb_add(unsigned* p, unsigned v) { return __hip_atomic_fetch_add(p, v, __ATOMIC_RELAXED, __HIP_MEMORY_SCOPE_AGENT); }
__device__ __forceinline__ unsigned xb_xcc_id() { return (unsigned)__builtin_amdgcn_s_getreg((3 << 11) | 20) & 0xFu; }
#define XB_SPIN(cond, bar) do { unsigned _sp = 0; while (cond) { __builtin_amdgcn_s_sleep(1); \
    if ((++_sp & 255u) == 0u) { if (xb_ld(&(bar)[XB_TMO])) break; if (_sp > XB_SPIN_CAP) { atomicAdd(&(bar)[XB_TMO], 1u); break; } } } } while (0)

struct XcdBarrier {
    unsigned* bar; unsigned x;
    volatile LAS unsigned* st;
};

__device__ __forceinline__ XcdBarrier xcd_barrier_post(unsigned* bar, volatile LAS unsigned* st) {
    XcdBarrier b; b.bar = bar; b.x = xb_xcc_id(); b.st = st;
    if (threadIdx.x == 0) (void)xb_add(&bar[XB_XCNT(b.x)], 1u);
    return b;
}
__device__ __forceinline__ void xcd_barrier_complete(unsigned* bar, unsigned x, unsigned& nloc, unsigned& nx) {
    const unsigned G = gridDim.x * gridDim.y * gridDim.z;
    unsigned sum, cnt, mine, sp = 0u;
    for (;;) {
        sum = 0u; cnt = 0u; mine = 0u;
#pragma unroll
        for (unsigned j = 0; j < 16; ++j) { const unsigned c = xb_ld(&bar[XB_XCNT(j)]); sum += c; cnt += (c > 0u) ? 1u : 0u; mine = (j == x) ? c : mine; }
        if (sum == G) break;
        __builtin_amdgcn_s_sleep(1);
        if ((++sp & 255u) == 0u) { if (xb_ld(&bar[XB_TMO])) break; if (sp > XB_SPIN_CAP) { atomicAdd(&bar[XB_TMO], 1u); break; } }
    }
    nloc = mine > 0u ? mine : 1u; nx = cnt > 0u ? cnt : 1u;
}

__device__ __forceinline__ void xcd_barrier(const XcdBarrier& b) {
    asm volatile("s_waitcnt vmcnt(0)" ::: "memory");
    __syncthreads();
    if (threadIdx.x == 0) {
        unsigned bz_ = 0; asm volatile("" : "+s"(bz_)); unsigned* bar = b.bar + bz_;
        __builtin_amdgcn_s_waitcnt(0);
        unsigned nloc = b.st[0], nx = b.st[1];
        if (nloc == 0u) { xcd_barrier_complete(bar, b.x, nloc, nx); b.st[0] = nloc; b.st[1] = nx; }
        const unsigned old = xb_add(&bar[XB_XSUB(b.x)], 1u);
        const unsigned gen = old / nloc;
        if (old + 1u == (gen + 1u) * nloc) {
            __builtin_amdgcn_fence(__ATOMIC_RELEASE, "agent");
            asm volatile("s_waitcnt vmcnt(0)" ::: "memory");
            const unsigned og = xb_add(&bar[XB_TOP], 1u);
            const unsigned tg = og / nx;
            if (og + 1u == (tg + 1u) * nx) xb_add(&bar[XB_TOPGEN], 1u);
            else XB_SPIN(xb_ld(&bar[XB_TOPGEN]) == tg, bar);
            __builtin_amdgcn_fence(__ATOMIC_ACQUIRE, "agent");
            xb_add(&bar[XB_XGEN(b.x)], 1u);
            asm volatile("s_waitcnt vmcnt(0)" ::: "memory");
        } else {
            XB_SPIN(xb_ld(&bar[XB_XGEN(b.x)]) == gen, bar);
            __builtin_amdgcn_fence(__ATOMIC_ACQUIRE, "agent");
            asm volatile("s_waitcnt vmcnt(0)" ::: "memory");
        }
    }
    __syncthreads();
}

struct Args { const float* in[24]; float* out; unsigned char* ws; int ph_lo, ph_hi; };
__device__ __forceinline__ float shx(int lane, float v, int o) { return __int_as_float(__builtin_amdgcn_ds_bpermute((lane ^ o) << 2, __float_as_int(v))); }
__device__ __forceinline__ float wave_sum(int lane, float v) {
#pragma unroll
    for (int o = 1; o < 64; o <<= 1) v += shx(lane, v, o);
    return v;
}
__device__ __forceinline__ float wave_max(int lane, float v) {
#pragma unroll
    for (int o = 1; o < 64; o <<= 1) v = fmaxf(v, shx(lane, v, o));
    return v;
}
__device__ __forceinline__ unsigned pk2(float lo, float hi) { return pg8::cvt_pk_bf16(lo, hi); }
__device__ __forceinline__ f32x4 zero_acc() { float z = 0.f; asm volatile("" : "+v"(z)); return (f32x4){z, z, z, z}; }
__device__ __forceinline__ float bf_lo(unsigned w) { return __uint_as_float(w << 16); }
__device__ __forceinline__ float bf_hi(unsigned w) { return __uint_as_float(w & 0xffff0000u); }
__device__ __forceinline__ float sigmoidf_(float x) { return 1.0f / (1.0f + expf(-x)); }
__device__ __forceinline__ float siluf_(float x) { return x / (1.0f + expf(-x)); }
#define LDS_WAIT() asm volatile("s_waitcnt lgkmcnt(0)" ::: "memory")

__device__ __forceinline__ void transpose_item(const float* W, int ldw, int k0, int ns0, int nvalid, bf16_t* WT, int K, int nd0, LAS float* scr, int lane, bool vec4) {
    if (vec4) { const int c4 = lane & 7, kr = lane >> 3;
#pragma unroll
        for (int i = 0; i < 8; ++i) { const int kk = 8 * i + kr; const f32x4 v = *(const f32x4*)(W + (size_t)(k0 + kk) * ldw + ns0 + 4 * c4);
            scr[kk * 33 + 4 * c4] = v.x; scr[kk * 33 + 4 * c4 + 1] = v.y; scr[kk * 33 + 4 * c4 + 2] = v.z; scr[kk * 33 + 4 * c4 + 3] = v.w; } }
    else { const int c = lane & 31;
#pragma unroll 8
        for (int i = 0; i < 32; ++i) { const int kk = 2 * i + (lane >> 5); scr[kk * 33 + c] = (c < nvalid) ? W[(size_t)(k0 + kk) * ldw + ns0 + c] : 0.f; } }
    LDS_WAIT(); asm volatile("" ::: "memory");
    const int c8 = lane & 7;
#pragma unroll
    for (int j = 0; j < 4; ++j) { const int n = (lane >> 3) + 8 * j; const LAS float* s = scr + (8 * c8) * 33 + n;
        u32x4 o; o.x = pk2(s[0 * 33], s[1 * 33]); o.y = pk2(s[2 * 33], s[3 * 33]); o.z = pk2(s[4 * 33], s[5 * 33]); o.w = pk2(s[6 * 33], s[7 * 33]);
        *(u32x4*)(WT + (size_t)(nd0 + n) * K + k0 + 8 * c8) = o; }
    LDS_WAIT(); asm volatile("" ::: "memory");
}
__device__ __forceinline__ void rmsnorm_row_bf16(const float* xrow, const float* gain, bf16_t* orow, int lane) {
    f32x4 v[8]; float ss = 0.f;
#pragma unroll
    for (int j = 0; j < 8; ++j) { v[j] = ((const f32x4*)xrow)[lane + 64 * j]; ss += (v[j].x * v[j].x + v[j].y * v[j].y) + (v[j].z * v[j].z + v[j].w * v[j].w); }
    const float r = rsqrtf(wave_sum(lane, ss) * (1.f / D) + EPS);
#pragma unroll
    for (int j = 0; j < 8; ++j) { const f32x4 g = ((const f32x4*)gain)[lane + 64 * j]; u32x2 w; w.x = pk2(v[j].x * r * g.x, v[j].y * r * g.y); w.y = pk2(v[j].z * r * g.z, v[j].w * r * g.w);
        ((u32x2*)orow)[lane + 64 * j] = w; }
}
constexpr int CV_GU = 2 * 352 * 32, CV_D = 2 * 64 * 88, CV_IN = 192 * 32, CV_OUT = 64 * 32, CV_GLU = 16 * 8, CV_ITEMS = CV_GU + CV_D + CV_IN + CV_OUT + CV_GLU;
__device__ __forceinline__ void convert_item(const Args& a, unsigned char* ws, int L, int it, LAS float* scr, int lane) {
    int r = it;
    if (r < CV_GU) { const int mi = L * 2 + r / (352 * 32), q = r % (352 * 32), kb = q / 352, ng = q % 352, nd0 = 32 * ng, pn = nd0 >> 8, wi = nd0 & 255, bj = wi >> 7, i = wi & 127;
        const float* W = (bj ? a.in[I_WU] : a.in[I_WG]) + (size_t)mi * D * DFF;
        transpose_item(W, DFF, 64 * kb, 128 * pn + i, 32, (bf16_t*)(ws + WS_WGU) + (size_t)mi * NGU * D, D, nd0, scr, lane, true); return; }
    r -= CV_GU;
    if (r < CV_D) { const int mi = L * 2 + r / (64 * 88), q = r % (64 * 88), kb = q / 64, ng = q % 64;
        transpose_item(a.in[I_WD] + (size_t)mi * DFF * D, D, 64 * kb, 32 * ng, 32, (bf16_t*)(ws + WS_WD) + (size_t)mi * D * DFF, DFF, 32 * ng, scr, lane, true); return; }
    r -= CV_D;
    if (r < CV_IN) { const int kb = r / 192, ng = r % 192; int nv = NIN - 32 * ng; nv = nv > 32 ? 32 : (nv < 0 ? 0 : nv);
        transpose_item(a.in[I_WIN] + (size_t)L * D * NIN, NIN, 64 * kb, 32 * ng, nv, (bf16_t*)(ws + WS_WIN) + (size_t)L * NINP * D, D, 32 * ng, scr, lane, nv == 32); return; }
    r -= CV_IN;
    if (r < CV_OUT) { const int kb = r / 64, ng = r % 64;
        transpose_item(a.in[I_WOUT] + (size_t)L * D * D, D, 64 * kb, 32 * ng, 32, (bf16_t*)(ws + WS_WOUT) + (size_t)L * D * D, D, 32 * ng, scr, lane, true); return; }
    r -= CV_OUT;
    { const int kb = r / 16, ng = r % 16;
        transpose_item(a.in[I_GLUW] + (size_t)L * 512 * 512, 512, 64 * kb, 32 * ng, 32, (bf16_t*)(ws + WS_WGLU) + (size_t)L * 512 * 512, 512, 32 * ng, scr, lane, true); }
}
__device__ __forceinline__ void p0_prologue(const Args& a, unsigned char* ws, LAS unsigned char* lds, int blk, int G, int tid) {
    const int lane = tid & 63, wave = __builtin_amdgcn_readfirstlane(tid >> 6), gw = blk * NWAVES + wave, ngw = G * NWAVES;
    LAS float* scr = (LAS float*)(lds + wave * 16384);
    for (int it = gw; it < CV_ITEMS; it += ngw) convert_item(a, ws, 0, it, scr, lane);
    for (int m = gw; m < M; m += ngw) rmsnorm_row_bf16(a.in[I_X] + (size_t)m * D, a.in[I_GAINS], (bf16_t*)(ws + WS_H) + (size_t)m * D, lane);
}
constexpr int CW_Q = 8192, CW_DONE = 8192 + 64 * 8;
__device__ __forceinline__ void conv_slot(const Args& a, unsigned char* ws, int L, int slot, unsigned target, LAS unsigned char* lds, volatile LAS unsigned* MISC, int tid) {
    if (L >= DEPTH) return;
    const int lane = tid & 63, wave = __builtin_amdgcn_readfirstlane(tid >> 6);
    unsigned* q = (unsigned*)(ws + WS_CTL) + CW_Q + 64 * L; unsigned* dn = (unsigned*)(ws + WS_CTL) + CW_DONE + 64 * slot;
    LAS float* scr = (LAS float*)(lds + wave * 16384);
    __syncthreads();
    if (target && tid == 0) __hip_atomic_fetch_add(dn, 1u, __ATOMIC_RELAXED, __HIP_MEMORY_SCOPE_AGENT);
    for (;;) {
        if (tid == 0) { unsigned base = 0xffffffffu;
            if (!target || __hip_atomic_load(dn, __ATOMIC_RELAXED, __HIP_MEMORY_SCOPE_AGENT) < target) base = __hip_atomic_fetch_add(q, 8u, __ATOMIC_RELAXED, __HIP_MEMORY_SCOPE_AGENT);
            MISC[16] = base; }
        __syncthreads();
        const unsigned base = MISC[16];
        __syncthreads();
        if (base >= (unsigned)CV_ITEMS) break;
        const int it = (int)base + wave;
        if (it < CV_ITEMS) convert_item(a, ws, L, it, scr, lane);
    }
}

__device__ __forceinline__ void bf8_to_f32(const u32x4 w, float (&o)[8]) { o[0] = bf_lo(w.x); o[1] = bf_hi(w.x); o[2] = bf_lo(w.y); o[3] = bf_hi(w.y); o[4] = bf_lo(w.z); o[5] = bf_hi(w.z); o[6] = bf_lo(w.w); o[7] = bf_hi(w.w); }
template <bool SRC_F32, bool DST_F32>
__device__ __forceinline__ void thin_phase(const void* xsrc, void* xdst, const bf16_t* y, const float* gpost, float scale, const float* gpre, bf16_t* h, int blk, int G, int tid) {
    const int lane = tid & 63, wave = __builtin_amdgcn_readfirstlane(tid >> 6), gw = blk * NWAVES + wave, ngw = G * NWAVES;
    for (int m = gw; m < M; m += ngw) {
        float yv[4][8], xv[4][8]; float ss = 0.f;
#pragma unroll
        for (int j = 0; j < 4; ++j) { bf8_to_f32(((const u32x4*)(y + (size_t)m * D))[lane + 64 * j], yv[j]);
            if (SRC_F32) { const f32x4 a0 = ((const f32x4*)((const float*)xsrc + (size_t)m * D))[(lane + 64 * j) * 2], a1 = ((const f32x4*)((const float*)xsrc + (size_t)m * D))[(lane + 64 * j) * 2 + 1];
                xv[j][0] = a0.x; xv[j][1] = a0.y; xv[j][2] = a0.z; xv[j][3] = a0.w; xv[j][4] = a1.x; xv[j][5] = a1.y; xv[j][6] = a1.z; xv[j][7] = a1.w; }
            else bf8_to_f32(((const u32x4*)((const bf16_t*)xsrc + (size_t)m * D))[lane + 64 * j], xv[j]);
#pragma unroll
            for (int i = 0; i < 8; ++i) ss += yv[j][i] * yv[j][i]; }
        const float r1 = rsqrtf(wave_sum(lane, ss) * (1.f / D) + EPS) * scale; float s2 = 0.f;
#pragma unroll
        for (int j = 0; j < 4; ++j) { const f32x4 g0 = ((const f32x4*)gpost)[(lane + 64 * j) * 2], g1 = ((const f32x4*)gpost)[(lane + 64 * j) * 2 + 1]; const float gg[8] = {g0.x, g0.y, g0.z, g0.w, g1.x, g1.y, g1.z, g1.w};
#pragma unroll
            for (int i = 0; i < 8; ++i) { xv[j][i] += yv[j][i] * r1 * gg[i]; s2 += xv[j][i] * xv[j][i]; }
            if (DST_F32) { ((f32x4*)((float*)xdst + (size_t)m * D))[(lane + 64 * j) * 2] = (f32x4){xv[j][0], xv[j][1], xv[j][2], xv[j][3]}; ((f32x4*)((float*)xdst + (size_t)m * D))[(lane + 64 * j) * 2 + 1] = (f32x4){xv[j][4], xv[j][5], xv[j][6], xv[j][7]}; }
            else { u32x4 w; w.x = pk2(xv[j][0], xv[j][1]); w.y = pk2(xv[j][2], xv[j][3]); w.z = pk2(xv[j][4], xv[j][5]); w.w = pk2(xv[j][6], xv[j][7]); ((u32x4*)((bf16_t*)xdst + (size_t)m * D))[lane + 64 * j] = w; } }
        if (h) { const float r2 = rsqrtf(wave_sum(lane, s2) * (1.f / D) + EPS);
#pragma unroll
            for (int j = 0; j < 4; ++j) { const f32x4 g0 = ((const f32x4*)gpre)[(lane + 64 * j) * 2], g1 = ((const f32x4*)gpre)[(lane + 64 * j) * 2 + 1];
                u32x4 w; w.x = pk2(xv[j][0] * r2 * g0.x, xv[j][1] * r2 * g0.y); w.y = pk2(xv[j][2] * r2 * g0.z, xv[j][3] * r2 * g0.w); w.z = pk2(xv[j][4] * r2 * g1.x, xv[j][5] * r2 * g1.y); w.w = pk2(xv[j][6] * r2 * g1.z, xv[j][7] * r2 * g1.w);
                ((u32x4*)(h + (size_t)m * D))[lane + 64 * j] = w; } }
    }
}

__device__ __forceinline__ void ssm_lambda(const Args& a, int l, int g, int p, float& ar, float& ai, float& cr, float& ci) {
    const float lr = a.in[I_LRE][(l * 32 + g) * 64 + p], li = a.in[I_LIM][(l * 32 + g) * 64 + p], dt = expf(a.in[I_LOGDT][l * 32 + g]);
    const float x = lr * dt, yy = li * dt; float sn, cs; sincosf(yy, &sn, &cs); const float mag = expf(x);
    ar = mag * cs; ai = mag * sn;
    const float sh = sinf(0.5f * yy); const float er = expm1f(x) * cs - 2.f * sh * sh, ei = ai;
    const float den = 1.f / (lr * lr + li * li); cr = (er * lr + ei * li) * den; ci = (ei * lr - er * li) * den;
}
__device__ __forceinline__ void ssm_local(const Args& a, unsigned char* ws, int l, int blk, int G, int tid, LAS unsigned char* lds) {
    const int lane = tid & 63, wave = __builtin_amdgcn_readfirstlane(tid >> 6), gw = blk * NWAVES + wave, ngw = G * NWAVES;
    const bf16_t* proj = (const bf16_t*)(ws + WS_PROJ); f32x2* E = (f32x2*)(ws + WS_SSME);
    LAS f32x4* ubuf = (LAS f32x4*)(lds + wave * 4096);
    for (int wu = gw; wu < 4096; wu += ngw) {
        const int b = wu >> 11, g = (wu >> 6) & 31, ch = wu & 63;
        const bf16_t* up = proj + (size_t)(b * SEQ + ch * 64) * NINP + PC_SSM + g * 16;
        const u32x4 ub0 = *(const u32x4*)(up + (size_t)lane * NINP), ub1 = *(const u32x4*)(up + (size_t)lane * NINP + 8);
        float ar, ai, cr, ci; ssm_lambda(a, l, g, lane, ar, ai, cr, ci);
        float bbr[16], bbi[16];
        { const f32x4* br = (const f32x4*)(a.in[I_BRE] + ((size_t)(l * 32 + g) * 64 + lane) * 16); const f32x4* bi = (const f32x4*)(a.in[I_BIM] + ((size_t)(l * 32 + g) * 64 + lane) * 16);
#pragma unroll
          for (int q = 0; q < 4; ++q) { const f32x4 x = br[q], y = bi[q];
#pragma unroll
              for (int e = 0; e < 4; ++e) { bbr[4 * q + e] = cr * x[e] - ci * y[e]; bbi[4 * q + e] = cr * y[e] + ci * x[e]; } } }
        { float t0[8], t1[8]; bf8_to_f32(ub0, t0); bf8_to_f32(ub1, t1);
          ubuf[lane * 4 + 0] = (f32x4){t0[0], t0[1], t0[2], t0[3]}; ubuf[lane * 4 + 1] = (f32x4){t0[4], t0[5], t0[6], t0[7]}; ubuf[lane * 4 + 2] = (f32x4){t1[0], t1[1], t1[2], t1[3]}; ubuf[lane * 4 + 3] = (f32x4){t1[4], t1[5], t1[6], t1[7]}; }
        LDS_WAIT(); asm volatile("" ::: "memory");
        f32x2 bb[16];
#pragma unroll
        for (int e = 0; e < 16; ++e) bb[e] = (f32x2){bbr[e], bbi[e]};
        f32x2 sv = {0.f, 0.f}; const f32x2 la = {ar, ar}, lb = {-ai, ai};
        for (int tg = 0; tg < 8; ++tg) { f32x4 ug[8][4];
#pragma unroll
            for (int tt = 0; tt < 8; ++tt)
#pragma unroll
                for (int q = 0; q < 4; ++q) ug[tt][q] = ubuf[(tg * 8 + tt) * 4 + q];
            __builtin_amdgcn_sched_barrier(0);
#pragma unroll
            for (int tt = 0; tt < 8; ++tt) { f32x2 bu0 = {0.f, 0.f}, bu1 = {0.f, 0.f};
#pragma unroll
                for (int q = 0; q < 4; ++q) { const f32x4 u = ug[tt][q];
                    bu0 += bb[4 * q + 0] * (f32x2){u[0], u[0]}; bu1 += bb[4 * q + 1] * (f32x2){u[1], u[1]}; bu0 += bb[4 * q + 2] * (f32x2){u[2], u[2]}; bu1 += bb[4 * q + 3] * (f32x2){u[3], u[3]}; }
                sv = la * sv + lb * (f32x2){sv.y, sv.x} + (bu0 + bu1); } }
        E[(size_t)wu * 64 + lane] = sv;
        LDS_WAIT(); asm volatile("" ::: "memory");
    }
}
__device__ __forceinline__ float gelu_tanh(float y) { return 0.5f * y * (1.0f + tanhf(0.7978845608028654f * (y + 0.044715f * y * y * y))); }
typedef short bf16x8s __attribute__((ext_vector_type(8)));
constexpr int SSM_WLDS = 4096 + 16 * 288;
__device__ __forceinline__ void ssm_final_unit(const Args& a, unsigned char* ws, int l, int wu, LAS unsigned char* wlds, int lane) {
    const bf16_t* proj = (const bf16_t*)(ws + WS_PROJ); const f32x2* E = (const f32x2*)(ws + WS_SSME);
    float* YG = (float*)(ws + WS_YG); bf16_t* YGB = (bf16_t*)(ws + WS_YGB);
    LAS f32x4* ubuf = (LAS f32x4*)wlds; LAS unsigned char* sH = wlds + 4096;
    const int b = wu >> 11, g = (wu >> 6) & 31, ch = wu & 63, fr = lane & 15, q4 = lane >> 4;
    const size_t row0 = (size_t)b * SEQ + ch * 64;
    const bf16_t* up = proj + row0 * NINP + PC_SSM + g * 16;
    const u32x4 ub0 = *(const u32x4*)(up + (size_t)lane * NINP), ub1 = *(const u32x4*)(up + (size_t)lane * NINP + 8);
    float ar, ai, cr, ci; ssm_lambda(a, l, g, lane, ar, ai, cr, ci);
    f32x2 bb[16];
    { const f32x4* br = (const f32x4*)(a.in[I_BRE] + ((size_t)(l * 32 + g) * 64 + lane) * 16); const f32x4* bi = (const f32x4*)(a.in[I_BIM] + ((size_t)(l * 32 + g) * 64 + lane) * 16);
#pragma unroll
      for (int q = 0; q < 4; ++q) { const f32x4 x = br[q], y = bi[q];
#pragma unroll
          for (int e = 0; e < 4; ++e) bb[4 * q + e] = (f32x2){cr * x[e] - ci * y[e], cr * y[e] + ci * x[e]}; } }
    bf16x8s Ah[4], Al[4];
    { const float* cre = a.in[I_CRE] + ((size_t)(l * 32 + g) * 16 + fr) * 64 + 4 * q4; const float* cim = a.in[I_CIM] + ((size_t)(l * 32 + g) * 16 + fr) * 64 + 4 * q4;
#pragma unroll
      for (int ks = 0; ks < 4; ++ks) { const f32x4 xr = *(const f32x4*)(cre + 16 * ks), xi = *(const f32x4*)(cim + 16 * ks);
          const float v[8] = {xr[0], -xi[0], xr[1], -xi[1], xr[2], -xi[2], xr[3], -xi[3]}; u32x4 wh, wl; unsigned hh[4], ll[4];
#pragma unroll
          for (int i = 0; i < 4; ++i) { hh[i] = pk2(v[2 * i], v[2 * i + 1]); ll[i] = pk2(v[2 * i] - bf_lo(hh[i]), v[2 * i + 1] - bf_hi(hh[i])); }
          wh.x = hh[0]; wh.y = hh[1]; wh.z = hh[2]; wh.w = hh[3]; wl.x = ll[0]; wl.y = ll[1]; wl.z = ll[2]; wl.w = ll[3];
          Ah[ks] = __builtin_bit_cast(bf16x8s, wh); Al[ks] = __builtin_bit_cast(bf16x8s, wl); } }
    { float t0[8], t1[8]; bf8_to_f32(ub0, t0); bf8_to_f32(ub1, t1);
      ubuf[lane * 4 + 0] = (f32x4){t0[0], t0[1], t0[2], t0[3]}; ubuf[lane * 4 + 1] = (f32x4){t0[4], t0[5], t0[6], t0[7]}; ubuf[lane * 4 + 2] = (f32x4){t1[0], t1[1], t1[2], t1[3]}; ubuf[lane * 4 + 3] = (f32x4){t1[4], t1[5], t1[6], t1[7]}; }
    float pr = ar, pi = ai;
#pragma unroll
    for (int q = 0; q < 6; ++q) { const float nr = pr * pr - pi * pi, ni = 2.f * pr * pi; pr = nr; pi = ni; }
    float sr = 0.f, si = 0.f;
    { const f32x2* e = E + (size_t)(wu - ch) * 64 + lane;
      for (int m0 = 0; m0 < ch; m0 += 16) { f32x2 ev[16];
#pragma unroll
          for (int i = 0; i < 16; ++i) { const int mm = m0 + i < ch ? m0 + i : ch - 1; ev[i] = e[(size_t)mm * 64]; }
#pragma unroll
          for (int i = 0; i < 16; ++i) if (m0 + i < ch) { const float nr = pr * sr - pi * si + ev[i].x, ni = pr * si + pi * sr + ev[i].y; sr = nr; si = ni; } } }
    const f32x4 dsk = *(const f32x4*)(a.in[I_SD] + l * 512 + g * 16 + 4 * q4);
    f32x2 sv = {sr, si}; const f32x2 la = {ar, ar}, lb = {-ai, ai};
    LDS_WAIT(); asm volatile("" ::: "memory");
    for (int tile = 0; tile < 4; ++tile) {
#pragma unroll
        for (int hg = 0; hg < 2; ++hg) { f32x4 ug[8][4];
#pragma unroll
            for (int tt = 0; tt < 8; ++tt)
#pragma unroll
                for (int q = 0; q < 4; ++q) ug[tt][q] = ubuf[(tile * 16 + hg * 8 + tt) * 4 + q];
            __builtin_amdgcn_sched_barrier(0);
#pragma unroll
            for (int tt = 0; tt < 8; ++tt) { f32x2 bu0 = {0.f, 0.f}, bu1 = {0.f, 0.f};
#pragma unroll
                for (int q = 0; q < 4; ++q) { const f32x4 u = ug[tt][q];
                    bu0 += bb[4 * q + 0] * (f32x2){u[0], u[0]}; bu1 += bb[4 * q + 1] * (f32x2){u[1], u[1]}; bu0 += bb[4 * q + 2] * (f32x2){u[2], u[2]}; bu1 += bb[4 * q + 3] * (f32x2){u[3], u[3]}; }
                sv = la * sv + lb * (f32x2){sv.y, sv.x} + (bu0 + bu1);
                *(LAS unsigned*)(sH + (hg * 8 + tt) * 288 + lane * 4) = pk2(sv.x, sv.y); } }
        LDS_WAIT(); asm volatile("" ::: "memory");
        bf16x8s Bh[4];
#pragma unroll
        for (int ks = 0; ks < 4; ++ks) Bh[ks] = *(const LAS bf16x8s*)(sH + fr * 288 + ks * 64 + q4 * 16);
        const f32x4 u4 = ubuf[(tile * 16 + fr) * 4 + q4];
        f32x4 acc = zero_acc(), acc2 = zero_acc();
#pragma unroll
        for (int ks = 0; ks < 4; ++ks) { acc = __builtin_amdgcn_mfma_f32_16x16x32_bf16(Ah[ks], Bh[ks], acc, 0, 0, 0); acc2 = __builtin_amdgcn_mfma_f32_16x16x32_bf16(Al[ks], Bh[ks], acc2, 0, 0, 0); }
        acc = acc + acc2;
        f32x4 vo;
#pragma unroll
        for (int r = 0; r < 4; ++r) { const float yv = acc[r] + dsk[r] * u4[r];
            const float zz = 0.7978845608028654f * (yv + 0.044715f * yv * yv * yv), th = 1.0f - 2.0f * __builtin_amdgcn_rcpf(__expf(2.0f * zz) + 1.0f); vo[r] = 0.5f * yv * (1.0f + th); }
        const size_t oidx = (row0 + tile * 16 + fr) * 512 + g * 16 + 4 * q4;
        *(f32x4*)(YG + oidx) = vo; u32x2 wb; wb.x = pk2(vo[0], vo[1]); wb.y = pk2(vo[2], vo[3]); *(u32x2*)(YGB + oidx) = wb;
        LDS_WAIT(); asm volatile("" ::: "memory");
    }
}

__device__ __forceinline__ void mix_phase(const Args& a, unsigned char* ws, int l, int blk, int G, int tid) {
    const int lane = tid & 63, wave = __builtin_amdgcn_readfirstlane(tid >> 6), gw = blk * NWAVES + wave, ngw = G * NWAVES;
    const bf16_t* proj = (const bf16_t*)(ws + WS_PROJ); const float* YG = (const float*)(ws + WS_YG); const float* Z = (const float*)(ws + WS_Z);
    const float* DO = (const float*)(ws + WS_DO); const bf16_t* AO = (const bf16_t*)(ws + WS_AO); const float* ALSE = (const float*)(ws + WS_ALSE);
    bf16_t* MIX = (bf16_t*)(ws + WS_MIX);
    const float* glub = a.in[I_GLUB] + l * 512; const float* sg = a.in[I_SGAIN] + l * 512; const float* dng = a.in[I_DNG] + l * 128; const float* atg = a.in[I_ATG] + l * 768;
    for (int m = gw; m < M; m += ngw) {
        const f32x4* yp = (const f32x4*)(YG + (size_t)m * 512 + 8 * lane); const f32x4* zp = (const f32x4*)(Z + (size_t)m * 512 + 8 * lane);
        const f32x4 y0 = yp[0], y1 = yp[1], z0 = zp[0], z1 = zp[1];
        f32x2 od[6]; unsigned zw[6], aw[6][3]; float ls[6][3];
#pragma unroll
        for (int h = 0; h < 6; ++h) { od[h] = *(const f32x2*)(DO + (size_t)m * 768 + h * 128 + 2 * lane); zw[h] = *(const unsigned*)(proj + (size_t)m * NINP + PC_DZ + h * 128 + 2 * lane);
#pragma unroll
            for (int g3 = 0; g3 < 3; ++g3) { ls[h][g3] = ALSE[((size_t)g3 * M + m) * 8 + h]; aw[h][g3] = *(const unsigned*)(AO + ((size_t)g3 * M + m) * 768 + h * 128 + 2 * lane); } }
        const f32x4* bp = (const f32x4*)(glub + 8 * lane); const f32x4 b0 = bp[0], b1 = bp[1];
        float red[8];
        float v[8];
#pragma unroll
        for (int e = 0; e < 4; ++e) { v[e] = y0[e] * sigmoidf_(z0[e] + b0[e]); v[4 + e] = y1[e] * sigmoidf_(z1[e] + b1[e]); }
        red[0] = 0.f;
#pragma unroll
        for (int e = 0; e < 8; ++e) red[0] += v[e] * v[e];
#pragma unroll
        for (int h = 0; h < 6; ++h) red[1 + h] = od[h].x * od[h].x + od[h].y * od[h].y;
        float oa[6][2]; red[7] = 0.f;
#pragma unroll
        for (int h = 0; h < 6; ++h) { const float mx = fmaxf(ls[h][0], fmaxf(ls[h][1], ls[h][2])); const float w0 = __expf(ls[h][0] - mx), w1 = __expf(ls[h][1] - mx), w2 = __expf(ls[h][2] - mx), inv = 1.f / (w0 + w1 + w2);
            oa[h][0] = (w0 * bf_lo(aw[h][0]) + w1 * bf_lo(aw[h][1]) + w2 * bf_lo(aw[h][2])) * inv; oa[h][1] = (w0 * bf_hi(aw[h][0]) + w1 * bf_hi(aw[h][1]) + w2 * bf_hi(aw[h][2])) * inv;
            red[7] += oa[h][0] * oa[h][0] + oa[h][1] * oa[h][1]; }
#pragma unroll
        for (int o = 1; o < 64; o <<= 1) {
#pragma unroll
            for (int i = 0; i < 8; ++i) red[i] += shx(lane, red[i], o); }
        { const float r = rsqrtf(red[0] * (1.f / 512.f) + EPS); const f32x4* gp = (const f32x4*)(sg + 8 * lane); const f32x4 g0 = gp[0], g1 = gp[1];
          u32x4 w; w.x = pk2(v[0] * r * g0.x, v[1] * r * g0.y); w.y = pk2(v[2] * r * g0.z, v[3] * r * g0.w); w.z = pk2(v[4] * r * g1.x, v[5] * r * g1.y); w.w = pk2(v[6] * r * g1.z, v[7] * r * g1.w);
          *(u32x4*)(MIX + (size_t)m * D + 8 * lane) = w; }
        { const f32x2 g = *(const f32x2*)(dng + 2 * lane);
#pragma unroll
          for (int h = 0; h < 6; ++h) { const float r = rsqrtf(red[1 + h] * (1.f / 128.f) + EPS);
              *(unsigned*)(MIX + (size_t)m * D + 512 + h * 128 + 2 * lane) = pk2(od[h].x * r * g.x * siluf_(bf_lo(zw[h])), od[h].y * r * g.y * siluf_(bf_hi(zw[h]))); } }
        { const float r = rsqrtf(red[7] * (1.f / 768.f) + EPS);
#pragma unroll
          for (int h = 0; h < 6; ++h) { const f32x2 g = *(const f32x2*)(atg + h * 128 + 2 * lane);
              *(unsigned*)(MIX + (size_t)m * D + 1280 + h * 128 + 2 * lane) = pk2(oa[h][0] * r * g.x, oa[h][1] * r * g.y); } }
    }
}

typedef pg8::StaticOrder GemmOrder;
typedef short bf16x8 __attribute__((ext_vector_type(8)));
__device__ __forceinline__ int kperm(int k) { return (k & ~31) + 8 * ((k & 15) >> 2) + 4 * ((k >> 4) & 1) + (k & 3); }
__device__ __forceinline__ bf16x8 pack8(const f32x4 a, const f32x4 b) { u32x4 w; w.x = pk2(a[0], a[1]); w.y = pk2(a[2], a[3]); w.z = pk2(b[0], b[1]); w.w = pk2(b[2], b[3]); return __builtin_bit_cast(bf16x8, w); }
constexpr int DP_KS = 0, DP_VS = 33024, DP_QS = 66048, DP_KB = 99072, DP_QB = 117504, DP_MISC = 135936, DP_ATL = 137216, DP_AP = 68;
__device__ __forceinline__ void dn_chunk_prep(const Args& a, unsigned char* ws, int l, int unit, LAS unsigned char* lds, int tid) {
    const int lane = tid & 63, wave = __builtin_amdgcn_readfirstlane(tid >> 6), q4 = lane >> 4, fr = lane & 15;
    const bf16_t* proj = (const bf16_t*)(ws + WS_PROJ);
    const int bh = unit >> 6, n = unit & 63, b = bh / 6, h = bh % 6, t0 = n * 64; const size_t row0 = (size_t)b * SEQ + t0;
    LAS float* ks = (LAS float*)(lds + DP_KS); LAS float* vs = (LAS float*)(lds + DP_VS); LAS float* qs = (LAS float*)(lds + DP_QS);
    LAS unsigned char* kb = lds + DP_KB; LAS unsigned char* qb = lds + DP_QB; LAS float* gcs = (LAS float*)(lds + DP_MISC); LAS float* bes = gcs + 64; LAS float* egs = gcs + 128;
    bf16_t* WN = (bf16_t*)(ws + WS_DWN) + (size_t)unit * 8192; bf16_t* QD = (bf16_t*)(ws + WS_DQD) + (size_t)unit * 8192; bf16_t* KT = (bf16_t*)(ws + WS_DKT) + (size_t)unit * 8192;
    bf16_t* AT = (bf16_t*)(ws + WS_DAT) + (size_t)unit * 4096; float* UD = (float*)(ws + WS_DUD) + (size_t)unit * 8192; float* CD = (float*)(ws + WS_DCD);
    const float* cw = a.in[I_CONVW] + (size_t)l * 4 * 2304;
    __syncthreads();
    { const int d2 = tid & 63, c0 = 8 * (tid >> 6); unsigned xin[3][11]; float wv[3][4][2];
#pragma unroll
      for (int w3 = 0; w3 < 3; ++w3) { const int chn = w3 * 768 + h * 128 + 2 * d2;
#pragma unroll
          for (int i = 0; i < 4; ++i) { const f32x2 w2 = *(const f32x2*)(cw + i * 2304 + chn); wv[w3][i][0] = w2.x; wv[w3][i][1] = w2.y; }
#pragma unroll
          for (int i = 0; i < 11; ++i) xin[w3][i] = (t0 + c0 - 3 + i >= 0) ? *(const unsigned*)(proj + (row0 + c0 - 3 + i) * NINP + PC_DQKV + chn) : 0u; }
#pragma unroll
      for (int w3 = 0; w3 < 3; ++w3) { LAS float* dst = w3 == 0 ? qs : (w3 == 1 ? ks : vs);
#pragma unroll
          for (int c = 0; c < 8; ++c) {
              const float a0 = wv[w3][0][0] * bf_lo(xin[w3][c]) + wv[w3][1][0] * bf_lo(xin[w3][c + 1]) + wv[w3][2][0] * bf_lo(xin[w3][c + 2]) + wv[w3][3][0] * bf_lo(xin[w3][c + 3]);
              const float a1 = wv[w3][0][1] * bf_hi(xin[w3][c]) + wv[w3][1][1] * bf_hi(xin[w3][c + 1]) + wv[w3][2][1] * bf_hi(xin[w3][c + 2]) + wv[w3][3][1] * bf_hi(xin[w3][c + 3]);
              dst[(c0 + c) * 129 + 2 * d2] = a0 * __builtin_amdgcn_rcpf(1.0f + __builtin_amdgcn_exp2f(-1.44269504089f * a0));
              dst[(c0 + c) * 129 + 2 * d2 + 1] = a1 * __builtin_amdgcn_rcpf(1.0f + __builtin_amdgcn_exp2f(-1.44269504089f * a1)); } } }
    if (wave == 0) { const size_t row = row0 + lane; const float av = __uint_as_float((unsigned)proj[row * NINP + PC_DA + h] << 16), bv = __uint_as_float((unsigned)proj[row * NINP + PC_DB + h] << 16);
        const float x = av + a.in[I_DTB][l * 6 + h]; const float sp = fmaxf(x, 0.f) + log1pf(expf(-fabsf(x))); float g = -expf(a.in[I_ALOG][l * 6 + h]) * sp;
#pragma unroll
        for (int o = 1; o < 64; o <<= 1) { const float t = __int_as_float(__builtin_amdgcn_ds_bpermute(((lane - o) & 63) << 2, __float_as_int(g))); if (lane >= o) g += t; }
        gcs[lane] = g; bes[lane] = sigmoidf_(bv); egs[lane] = expf(g); if (lane == 63) CD[unit] = expf(g); }
    __syncthreads();
    { const int c = wave * 8 + (lane >> 3), sg = lane & 7; float qv[16], kv[16]; float sq = 0.f, sk = 0.f;
#pragma unroll
      for (int i = 0; i < 16; ++i) { qv[i] = qs[c * 129 + 16 * sg + i]; kv[i] = ks[c * 129 + 16 * sg + i]; sq += qv[i] * qv[i]; sk += kv[i] * kv[i]; }
#pragma unroll
      for (int o = 1; o < 8; o <<= 1) { sq += shx(lane, sq, o); sk += shx(lane, sk, o); }
      const float qsc = rsqrtf(sq + EPS) * 0.08838834764831845f, ksc = rsqrtf(sk + EPS);
#pragma unroll
      for (int i = 0; i < 16; ++i) { qv[i] *= qsc; kv[i] *= ksc; qs[c * 129 + 16 * sg + i] = qv[i]; ks[c * 129 + 16 * sg + i] = kv[i]; }
      u32x4 w0, w1; w0.x = pk2(qv[0], qv[1]); w0.y = pk2(qv[2], qv[3]); w0.z = pk2(qv[4], qv[5]); w0.w = pk2(qv[6], qv[7]); w1.x = pk2(qv[8], qv[9]); w1.y = pk2(qv[10], qv[11]); w1.z = pk2(qv[12], qv[13]); w1.w = pk2(qv[14], qv[15]);
      *(LAS u32x4*)(qb + c * 288 + sg * 32) = w0; *(LAS u32x4*)(qb + c * 288 + sg * 32 + 16) = w1;
      w0.x = pk2(kv[0], kv[1]); w0.y = pk2(kv[2], kv[3]); w0.z = pk2(kv[4], kv[5]); w0.w = pk2(kv[6], kv[7]); w1.x = pk2(kv[8], kv[9]); w1.y = pk2(kv[10], kv[11]); w1.z = pk2(kv[12], kv[13]); w1.w = pk2(kv[14], kv[15]);
      *(LAS u32x4*)(kb + c * 288 + sg * 32) = w0; *(LAS u32x4*)(kb + c * 288 + sg * 32 + 16) = w1; }
    __syncthreads();
    { const float gl = gcs[63];
      for (int it = 0; it < 16; ++it) { const int idx = it * NTHR + tid, c = idx >> 7, d = idx & 127;
          const int p = d, blk32 = p & ~31, pp = p & 31, qq = pp >> 3, jj = pp & 7, dk = blk32 + ((jj < 4) ? 4 * qq + jj : 16 + 4 * qq + (jj - 4));
          QD[c * 128 + p] = (bf16_t)(pk2(qs[c * 129 + dk] * egs[c], 0.f) & 0xffffu); }
      for (int it = 0; it < 16; ++it) { const int idx = it * NTHR + tid, dk = idx >> 6, p = idx & 63;
          const int blk32 = p & ~31, pp = p & 31, qq = pp >> 3, jj = pp & 7, c = blk32 + ((jj < 4) ? 4 * qq + jj : 16 + 4 * qq + (jj - 4));
          KT[dk * 64 + p] = (bf16_t)(pk2(ks[c * 129 + dk] * expf(gl - gcs[c]), 0.f) & 0xffffu); } }
    __syncthreads();
    LAS float* Am = qs;
    for (int job = wave; job < 32; job += NWAVES) { const int kind = job >> 4, ti = (job >> 2) & 3, tj = job & 3;
        f32x4 acc = zero_acc();
        if (ti >= tj) { const LAS unsigned char* ab = (kind ? qb : kb) + (16 * ti + fr) * 288 + q4 * 16; const LAS unsigned char* bb = kb + (16 * tj + fr) * 288 + q4 * 16;
#pragma unroll
            for (int k4 = 0; k4 < 4; ++k4) acc = __builtin_amdgcn_mfma_f32_16x16x32_bf16(*(const LAS bf16x8*)(ab + k4 * 64), *(const LAS bf16x8*)(bb + k4 * 64), acc, 0, 0, 0); }
        const int e = 16 * tj + fr; const float ge = gcs[e];
#pragma unroll
        for (int r = 0; r < 4; ++r) { const int c = 16 * ti + 4 * q4 + r; const float dec = expf(fminf(gcs[c] - ge, 0.f));
            if (kind == 0) { Am[c * DP_AP + e] = (c > e) ? bes[c] * acc[r] * dec : 0.f; }
            else { *(LAS bf16_t*)(lds + DP_ATL + c * 144 + kperm(e) * 2) = (bf16_t)(pk2((c >= e) ? acc[r] * dec : 0.f, 0.f) & 0xffffu); } } }
    __syncthreads();
    { const int c = tid >> 3, pc = tid & 7; *(u32x4*)(AT + c * 64 + pc * 8) = *(const LAS u32x4*)(lds + DP_ATL + c * 144 + pc * 16); }
    if (tid < 256) { const int col = tid & 127; const bool isw = tid >= 128; float x[64]; int zoff = 0; asm volatile("" : "+v"(zoff));
        const LAS float* Amv = Am + zoff;
#pragma unroll
        for (int c = 0; c < 64; ++c) x[c] = isw ? ks[c * 129 + col] * bes[c] * egs[c] : vs[c * 129 + col] * bes[c];
#pragma unroll
        for (int c = 1; c < 64; ++c) { float s0 = x[c], s1 = 0.f, s2 = 0.f, s3 = 0.f;
#pragma unroll
            for (int e4 = 0; e4 < (c + 3) / 4; ++e4) { const f32x4 av = *(const LAS f32x4*)(Amv + c * DP_AP + 4 * e4);
                if (4 * e4 + 0 < c) s0 -= av[0] * x[4 * e4 + 0]; if (4 * e4 + 1 < c) s1 -= av[1] * x[4 * e4 + 1];
                if (4 * e4 + 2 < c) s2 -= av[2] * x[4 * e4 + 2]; if (4 * e4 + 3 < c) s3 -= av[3] * x[4 * e4 + 3]; }
            x[c] = (s0 + s1) + (s2 + s3); }
        if (!isw) { const int s8 = col >> 4, f = col & 15;
#pragma unroll
            for (int mt = 0; mt < 4; ++mt)
#pragma unroll
                for (int qq = 0; qq < 4; ++qq) *(f32x4*)(UD + ((size_t)((s8 * 4 + mt) * 64 + qq * 16 + f)) * 4) = (f32x4){x[16 * mt + 4 * qq], x[16 * mt + 4 * qq + 1], x[16 * mt + 4 * qq + 2], x[16 * mt + 4 * qq + 3]}; }
        else { const int p = kperm(col);
#pragma unroll
            for (int c = 0; c < 64; ++c) *(LAS bf16_t*)(kb + c * 288 + p * 2) = (bf16_t)(pk2(-x[c], 0.f) & 0xffffu); } }
    __syncthreads();
#pragma unroll
    for (int i = 0; i < 2; ++i) { const int pi = tid + NTHR * i, c = pi >> 4, pc = pi & 15; *(u32x4*)(WN + c * 128 + pc * 8) = *(const LAS u32x4*)(kb + c * 288 + pc * 16); }
}
constexpr int DS2_WN = 0, DS2_KT = 18432, DS2_BYTES = 38912;
__device__ __forceinline__ void dn_scan_wg2(unsigned char* ws, int bh, int half, LAS unsigned char* lds, int tid) {
    const int lane = tid & 63, wv = __builtin_amdgcn_readfirstlane(tid >> 6), s8 = half * 4 + (wv & 3), q4 = lane >> 4, fr = lane & 15; const bool cw = wv < 4;
    const f32x4 z4 = {0.f, 0.f, 0.f, 0.f};
    f32x4 S[8]; bf16x8 Sb[4];
#pragma unroll
    for (int i = 0; i < 8; ++i) S[i] = z4;
#pragma unroll
    for (int i = 0; i < 4; ++i) Sb[i] = pack8(z4, z4);
    const int r16a = tid >> 4, pc16 = tid & 15, r8a = tid >> 3, pc8 = tid & 7;
    const unsigned char* gWN = ws + WS_DWN + (size_t)bh * 64 * 16384; const unsigned char* gKT = ws + WS_DKT + (size_t)bh * 64 * 16384;
    const f32x4* gUD = (const f32x4*)(ws + WS_DUD) + ((size_t)bh * 64 * 8 + s8) * 256 + lane;
    bf16x8* gSS = (bf16x8*)(ws + WS_DSS) + ((size_t)bh * 64 * 8 + s8) * 256 + lane; bf16x8* gVN = (bf16x8*)(ws + WS_DVN) + ((size_t)bh * 64 * 8 + s8) * 128 + lane;
    u32x4 st[4]; f32x4 udn[4]; float decn;
    const float* gCD = (const float*)(ws + WS_DCD) + bh * 64;
#define DN_LOAD2(n_) do { const size_t o16 = (size_t)(n_) * 16384; \
        st[0] = *(const u32x4*)(gWN + o16 + r16a * 256 + pc16 * 16); st[1] = *(const u32x4*)(gWN + o16 + (r16a + 32) * 256 + pc16 * 16); \
        st[2] = *(const u32x4*)(gKT + o16 + r8a * 128 + pc8 * 16); st[3] = *(const u32x4*)(gKT + o16 + (r8a + 64) * 128 + pc8 * 16); \
        decn = gCD[n_]; \
        if (cw) { _Pragma("unroll") for (int mt = 0; mt < 4; ++mt) udn[mt] = gUD[(size_t)(n_) * 2048 + mt * 64]; } } while (0)
    DN_LOAD2(0);
    const LAS unsigned char* aW = lds + DS2_WN + fr * 288 + q4 * 16; const LAS unsigned char* aK = lds + DS2_KT + fr * 160 + q4 * 16;
    for (int n = 0; n < 64; ++n) {
        __syncthreads();
        *(LAS u32x4*)(lds + DS2_WN + r16a * 288 + pc16 * 16) = st[0]; *(LAS u32x4*)(lds + DS2_WN + (r16a + 32) * 288 + pc16 * 16) = st[1];
        *(LAS u32x4*)(lds + DS2_KT + r8a * 160 + pc8 * 16) = st[2]; *(LAS u32x4*)(lds + DS2_KT + (r8a + 64) * 160 + pc8 * 16) = st[3];
        f32x4 vn[4];
#pragma unroll
        for (int mt = 0; mt < 4; ++mt) vn[mt] = udn[mt];
        const float dec = decn;
        if (cw) {
#pragma unroll
        for (int i = 0; i < 4; ++i) gSS[(size_t)n * 2048 + i * 64] = Sb[i]; }
        { const int nn = n + 1 < 64 ? n + 1 : 63; DN_LOAD2(nn); }
        __syncthreads();
        if (cw) {
        bf16x8 fw[16], fk[16];
#pragma unroll
        for (int i = 0; i < 16; ++i) fw[i] = *(const LAS bf16x8*)(aW + (i >> 2) * 16 * 288 + (i & 3) * 64);
        __builtin_amdgcn_sched_barrier(0);
#pragma unroll
        for (int k4 = 0; k4 < 4; ++k4)
#pragma unroll
            for (int mt = 0; mt < 4; ++mt) vn[mt] = __builtin_amdgcn_mfma_f32_16x16x32_bf16(fw[mt * 4 + k4], Sb[k4], vn[mt], 0, 0, 0);
        __builtin_amdgcn_sched_barrier(0);
#pragma unroll
        for (int i = 0; i < 16; ++i) fk[i] = *(const LAS bf16x8*)(aK + (i >> 1) * 16 * 160 + (i & 1) * 64);
#pragma unroll
        for (int t8 = 0; t8 < 8; ++t8) S[t8] = S[t8] * dec;
        bf16x8 Vb[2]; Vb[0] = pack8(vn[0], vn[1]); Vb[1] = pack8(vn[2], vn[3]);
        gVN[(size_t)n * 1024] = Vb[0]; gVN[(size_t)n * 1024 + 64] = Vb[1];
        __builtin_amdgcn_sched_barrier(0);
#pragma unroll
        for (int k2 = 0; k2 < 2; ++k2)
#pragma unroll
            for (int t8 = 0; t8 < 8; ++t8) S[t8] = __builtin_amdgcn_mfma_f32_16x16x32_bf16(fk[t8 * 2 + k2], Vb[k2], S[t8], 0, 0, 0);
#pragma unroll
        for (int i = 0; i < 4; ++i) Sb[i] = pack8(S[2 * i], S[2 * i + 1]);
        }
    }
#undef DN_LOAD2
    __syncthreads();
}
__device__ __forceinline__ void dn_out_unit(unsigned char* ws, int unit, int tid) {
    const int lane = tid & 63, s8 = __builtin_amdgcn_readfirstlane(tid >> 6), q4 = lane >> 4, fr = lane & 15;
    const int bh = unit >> 6, n = unit & 63, b = bh / 6, h = bh % 6;
    const bf16_t* qd = (const bf16_t*)(ws + WS_DQD) + (size_t)unit * 8192 + fr * 128 + q4 * 8; const bf16_t* at = (const bf16_t*)(ws + WS_DAT) + (size_t)unit * 4096 + fr * 64 + q4 * 8;
    const bf16x8* gSS = (const bf16x8*)(ws + WS_DSS) + ((size_t)unit * 8 + s8) * 256 + lane; const bf16x8* gVN = (const bf16x8*)(ws + WS_DVN) + ((size_t)unit * 8 + s8) * 128 + lane;
    bf16x8 Sb[4], Vb[2], fq[16], fa[8];
#pragma unroll
    for (int i = 0; i < 4; ++i) Sb[i] = gSS[i * 64];
    Vb[0] = gVN[0]; Vb[1] = gVN[64];
#pragma unroll
    for (int i = 0; i < 16; ++i) fq[i] = *(const bf16x8*)(qd + (i >> 2) * 2048 + (i & 3) * 32);
#pragma unroll
    for (int i = 0; i < 8; ++i) fa[i] = *(const bf16x8*)(at + (i >> 1) * 1024 + (i & 1) * 32);
    __builtin_amdgcn_sched_barrier(0);
    f32x4 o[4]; float* DO = (float*)(ws + WS_DO);
#pragma unroll
    for (int mt = 0; mt < 4; ++mt) o[mt] = zero_acc();
#pragma unroll
    for (int k4 = 0; k4 < 4; ++k4)
#pragma unroll
        for (int mt = 0; mt < 4; ++mt) o[mt] = __builtin_amdgcn_mfma_f32_16x16x32_bf16(fq[mt * 4 + k4], Sb[k4], o[mt], 0, 0, 0);
#pragma unroll
    for (int k2 = 0; k2 < 2; ++k2)
#pragma unroll
        for (int mt = 0; mt < 4; ++mt) o[mt] = __builtin_amdgcn_mfma_f32_16x16x32_bf16(fa[mt * 2 + k2], Vb[k2], o[mt], 0, 0, 0);
#pragma unroll
    for (int mt = 0; mt < 4; ++mt) { float* orow = DO + ((size_t)b * SEQ + n * 64 + 16 * mt + 4 * q4) * 768 + h * 128 + 16 * s8 + fr;
#pragma unroll
        for (int r = 0; r < 4; ++r) orow[(size_t)r * 768] = o[mt][r]; }
}

typedef short s16x4 __attribute__((ext_vector_type(4)));
constexpr int A2_K = 0, A2_V = 73728, A2_BIAS = 147456, A2_P = 288;
__device__ __forceinline__ s16x4 tr_read(const LAS unsigned char* p) { return __builtin_bit_cast(s16x4, __builtin_amdgcn_ds_read_tr16_b64_v4i16((LAS s16x4*)p)); }
__device__ __forceinline__ void attn_unit_mfma(const Args& a, unsigned char* ws, int unit, LAS unsigned char* lds, int tid) {
    const int lane = tid & 63, w = __builtin_amdgcn_readfirstlane(tid >> 6), q4 = lane >> 4, fr = lane & 15;
    const bf16_t* proj = (const bf16_t*)(ws + WS_PROJ);
    const int gi = unit / 384, rem = unit % 384, b = rem / 192, h = (rem >> 5) % 6, idx = rem & 31;
    const int dl = gi == 0 ? 1 : (gi == 1 ? 4 : 16), r = idx % dl, qb = idx / dl, i0 = qb * 128;
    bf16_t* AO = (bf16_t*)(ws + WS_AO) + (size_t)gi * M * 768; float* ALSE = (float*)(ws + WS_ALSE) + (size_t)gi * M * 8;
    LAS unsigned char* Kl = lds + A2_K; LAS unsigned char* Vl = lds + A2_V; LAS float* biasT = (LAS float*)(lds + A2_BIAS);
    __syncthreads();
    { u32x4 kw[8], vw[8];
#pragma unroll
      for (int i = 0; i < 8; ++i) { const int it = tid + NTHR * i, kk = it >> 4, c8 = it & 15, j = i0 - 128 + kk; const int jj = j < 0 ? 0 : j;
          const size_t row = (size_t)b * SEQ + (size_t)jj * dl + r; kw[i] = *(const u32x4*)(proj + row * NINP + PC_AK + h * 128 + 8 * c8); vw[i] = *(const u32x4*)(proj + row * NINP + PC_AV + h * 128 + 8 * c8); }
#pragma unroll
      for (int i = 0; i < 8; ++i) { const int it = tid + NTHR * i, kk = it >> 4, c8 = it & 15;
          *(LAS u32x4*)(Kl + kk * A2_P + c8 * 16) = kw[i]; *(LAS u32x4*)(Vl + kk * A2_P + c8 * 16) = vw[i]; } }
    if (tid < 129) { const int dist = tid * dl; int bucket;
        if (dist < 16) bucket = dist; else { const float lg = 16.f + logf((float)dist / 16.f) / 4.852030263919617f * 16.f; bucket = (int)lg; bucket = bucket > 31 ? 31 : bucket; }
        biasT[tid] = a.in[I_RELB][bucket * 6 + h]; }
    const size_t qrow = (size_t)b * SEQ + (size_t)(i0 + 16 * w + fr) * dl + r;
    bf16x8 Qf[4];
    { const bf16_t* qp = proj + qrow * NINP + PC_AQ + h * 128 + 8 * q4;
#pragma unroll
      for (int ks = 0; ks < 4; ++ks) Qf[ks] = *(const bf16x8*)(qp + 32 * ks); }
    __syncthreads();
    f32x4 sc9[9]; float mx = -1e30f;
#pragma unroll
    for (int t = 0; t < 9; ++t) { f32x4 acc = zero_acc(); const LAS unsigned char* kr = Kl + (16 * (w + t) + fr) * A2_P + q4 * 16;
#pragma unroll
        for (int ks = 0; ks < 4; ++ks) acc = __builtin_amdgcn_mfma_f32_16x16x32_bf16(*(const LAS bf16x8*)(kr + ks * 64), Qf[ks], acc, 0, 0, 0);
#pragma unroll
        for (int e = 0; e < 4; ++e) { const int rel = 128 + fr - 16 * t - 4 * q4 - e, kl = 16 * (w + t) + 4 * q4 + e; const bool valid = (rel >= 0) && (rel <= 128) && (i0 - 128 + kl >= 0);
            const float s = valid ? acc[e] * 0.08838834764831845f + biasT[rel < 0 ? 0 : (rel > 128 ? 128 : rel)] : -1e30f; acc[e] = s; mx = fmaxf(mx, s); }
        sc9[t] = acc; }
    mx = fmaxf(mx, shx(lane, mx, 16)); mx = fmaxf(mx, shx(lane, mx, 32));
    float sum = 0.f;
#pragma unroll
    for (int t = 0; t < 9; ++t)
#pragma unroll
        for (int e = 0; e < 4; ++e) { const float p = __expf(sc9[t][e] - mx); sc9[t][e] = p; sum += p; }
    sum += shx(lane, sum, 16); sum += shx(lane, sum, 32);
    f32x4 o[8];
#pragma unroll
    for (int dt = 0; dt < 8; ++dt) o[dt] = zero_acc();
    const f32x4 z4 = {0.f, 0.f, 0.f, 0.f};
#pragma unroll
    for (int s = 0; s < 5; ++s) { const bf16x8 Pf = pack8(sc9[2 * s], s < 4 ? sc9[2 * s + 1] : z4);
        const LAS unsigned char* v0 = Vl + (16 * w + 32 * s + 4 * q4 + (fr >> 2)) * A2_P + 8 * (fr & 3); const LAS unsigned char* v1 = s < 4 ? v0 + 16 * A2_P : v0;
#pragma unroll
        for (int dt = 0; dt < 8; ++dt) { const s16x4 lo = tr_read(v0 + dt * 32), hi = tr_read(v1 + dt * 32);
            const bf16x8 Vf = {lo[0], lo[1], lo[2], lo[3], hi[0], hi[1], hi[2], hi[3]};
            o[dt] = __builtin_amdgcn_mfma_f32_16x16x32_bf16(Vf, Pf, o[dt], 0, 0, 0); } }
    const float inv = 1.f / sum;
    bf16_t* orow = AO + qrow * 768 + h * 128 + 4 * q4;
#pragma unroll
    for (int dt = 0; dt < 8; ++dt) { u32x2 w; w.x = pk2(o[dt][0] * inv, o[dt][1] * inv); w.y = pk2(o[dt][2] * inv, o[dt][3] * inv); *(u32x2*)(orow + 16 * dt) = w; }
    if (q4 == 0) ALSE[qrow * 8 + h] = mx + logf(sum);
}

constexpr int PH_PER_LAYER = 13, NPH = 1 + PH_PER_LAYER * DEPTH;
__global__ void __launch_bounds__(NTHR, 2) fwd_kernel(Args args) {
    extern __shared__ __attribute__((aligned(16))) unsigned char lds_raw[];
    LAS unsigned char* lds = (LAS unsigned char*)lds_raw;
    volatile LAS unsigned* MISC = (volatile LAS unsigned*)(lds + MISC_OFF);
    const int tid = threadIdx.x;
    const int G = gridDim.x, blk = blockIdx.x;
    const int lo = args.ph_lo, hi = args.ph_hi;
    unsigned char* ws = args.ws;
    if (tid < 64) MISC[tid] = 0u;
    __syncthreads();
    XcdBarrier bar; bar.bar = (unsigned*)(ws + WS_CTL) + CW_BAR; bar.x = 0; bar.st = nullptr;
    if (hi - lo > 1) bar = xcd_barrier_post((unsigned*)(ws + WS_CTL) + CW_BAR, MISC + 8);
#define IN(k) (lo <= (k) && (k) < hi)
#define FRESH() int tidl = tid; unsigned wz_ = 0; asm volatile("" : "+v"(tidl), "+s"(wz_)); unsigned char* wsl = ws + wz_
#define SEAM(k) do { if (IN(k) && IN((k) + 1)) xcd_barrier(bar); } while (0)

    if (IN(0)) { FRESH(); p0_prologue(args, wsl, lds, blk, G, tidl); }
    SEAM(0);
    for (int l = 0; l < DEPTH; ++l) {
        const int pb = 1 + PH_PER_LAYER * l;
        const float* gains = args.in[I_GAINS] + (size_t)l * 6 * D;
#pragma unroll
        for (int f = 0; f < 2; ++f) {
            const int p0 = pb + (f ? 10 : 0);
            if (IN(p0)) {
                FRESH(); pg8::Gemm g{(const bf16_t*)(wsl + WS_H), (const bf16_t*)(wsl + WS_WGU) + (size_t)(l * 2 + f) * NGU * D, M, NGU, D};
                pg8::EpiSwiGLU E{(bf16_t*)(wsl + WS_ACT), DFF};
                GemmOrder S; S.init(M, NGU, G, blk); pg8::gemm_phase<pg8::EpiSwiGLU, GemmOrder, true, true>(lds, g, S, E, tidl);
                conv_slot(args, wsl, l + 1, l * 3 + f, (unsigned)G, lds, MISC, tidl);
            }
            SEAM(p0);
            if (IN(p0 + 1)) {
                FRESH(); pg8::Gemm g{(const bf16_t*)(wsl + WS_ACT), (const bf16_t*)(wsl + WS_WD) + (size_t)(l * 2 + f) * D * DFF, M, D, DFF}; GemmOrder S; S.init(M, D, G, blk);
                pg8::EpiBf16P E{(bf16_t*)(wsl + WS_Y), D};
                pg8::gemm_phase<pg8::EpiBf16P, GemmOrder, true, true>(lds, g, S, E, tidl);
            }
            SEAM(p0 + 1);
            if (IN(p0 + 2)) {
                const bool last = (f == 1 && l == DEPTH - 1);
                if (f == 1) { FRESH(); conv_slot(args, wsl, l + 1, 15, 0u, lds, MISC, tidl); }
                FRESH(); bf16_t* X = (bf16_t*)(wsl + WS_X); const bf16_t* Yb = (const bf16_t*)(wsl + WS_Y); bf16_t* Hb = (bf16_t*)(wsl + WS_H);
                const float* gpre = f == 0 ? gains + 2 * D : (last ? gains : args.in[I_GAINS] + (size_t)(l + 1) * 6 * D); const float* gpost = gains + (f ? 5 : 1) * D;
                if (f == 0 && l == 0) thin_phase<true, false>(args.in[I_X], X, Yb, gpost, 0.5f, gpre, Hb, blk, G, tidl);
                else if (last) thin_phase<false, true>(X, args.out, Yb, gpost, 0.5f, gpre, (bf16_t*)nullptr, blk, G, tidl);
                else thin_phase<false, false>(X, X, Yb, gpost, 0.5f, gpre, Hb, blk, G, tidl);
            }
            SEAM(p0 + 2);
            if (f == 1) break;
            if (IN(pb + 3)) {
                FRESH(); pg8::Gemm g{(const bf16_t*)(wsl + WS_H), (const bf16_t*)(wsl + WS_WIN) + (size_t)l * NINP * D, M, NINP, D}; GemmOrder S; S.init(M, NINP, G, blk);
                pg8::EpiBf16P E{(bf16_t*)(wsl + WS_PROJ), NINP};
                pg8::gemm_phase<pg8::EpiBf16P, GemmOrder, true, true>(lds, g, S, E, tidl);
            }
            SEAM(pb + 3);
            if (IN(pb + 4)) { FRESH();
                ssm_local(args, wsl, l, blk, G, tidl, lds);
                for (int u = blk; u < 768; u += G) dn_chunk_prep(args, wsl, l, u, lds, tidl); }
            SEAM(pb + 4);
            if (IN(pb + 5)) {
                FRESH(); const int lane = tidl & 63, wave = __builtin_amdgcn_readfirstlane(tidl >> 6), gw = blk * NWAVES + wave, ngw = G * NWAVES;
                if (blk < 24) { dn_scan_wg2(wsl, blk >> 1, blk & 1, lds, tidl); }
                if (blk >= 24) for (int wu = (blk - 24) * NWAVES + wave; wu < 4096; wu += (G - 24) * NWAVES) ssm_final_unit(args, wsl, l, wu, lds + wave * SSM_WLDS, lane);
                __syncthreads();
                if (blk >= 24) for (int u = blk - 24; u < 1152; u += G - 24) attn_unit_mfma(args, wsl, u, lds, tidl);
                conv_slot(args, wsl, l + 1, l * 3 + 2, (unsigned)G, lds, MISC, tidl);
            }
            SEAM(pb + 5);
            if (IN(pb + 6)) {
                if (blk >= 64) { FRESH(); for (int u = blk - 64; u < 768; u += G - 64) dn_out_unit(wsl, u, tidl); }
                FRESH(); pg8::Gemm g{(const bf16_t*)(wsl + WS_YGB), (const bf16_t*)(wsl + WS_WGLU) + (size_t)l * 512 * 512, M, 512, 512}; GemmOrder S; S.init(M, 512, G, blk);
                pg8::EpiF32 E{(float*)(wsl + WS_Z), 512};
                pg8::gemm_phase<pg8::EpiF32, GemmOrder, true, true>(lds, g, S, E, tidl);
            }
            SEAM(pb + 6);
            if (IN(pb + 7)) { FRESH(); mix_phase(args, wsl, l, blk, G, tidl);
            }
            SEAM(pb + 7);
            if (IN(pb + 8)) {
                FRESH(); pg8::Gemm g{(const bf16_t*)(wsl + WS_MIX), (const bf16_t*)(wsl + WS_WOUT) + (size_t)l * D * D, M, D, D}; GemmOrder S; S.init(M, D, G, blk);
                pg8::EpiBf16P E{(bf16_t*)(wsl + WS_Y), D};
                pg8::gemm_phase<pg8::EpiBf16P, GemmOrder, true, true>(lds, g, S, E, tidl);
            }
            SEAM(pb + 8);
            if (IN(pb + 9)) { FRESH(); bf16_t* X = (bf16_t*)(wsl + WS_X); thin_phase<false, false>(X, X, (const bf16_t*)(wsl + WS_Y), gains + 3 * D, 1.0f, gains + 4 * D, (bf16_t*)(wsl + WS_H), blk, G, tidl); }
            SEAM(pb + 9);
        }
    }
#undef IN
#undef SEAM
}

#ifndef MK_ONE_LAUNCH
#define MK_ONE_LAUNCH 1
#endif
extern "C" void kernel_launch(void* const* d_in, const int* in_sizes, int n_in, void* d_out, int out_size, void* d_ws, size_t ws_size, hipStream_t stream) {
    static int grid = 0;
    if (grid == 0) {
        if (n_in != N_IN || in_sizes[0] != M * D || out_size != M * D || ws_size < WS_END) { fprintf(stderr, "kernel_launch: unexpected shapes (n_in %d, in0 %d, out %d, ws %zu, need %zu)\n", n_in, n_in > 0 ? in_sizes[0] : -1, out_size, ws_size, (size_t)WS_END); grid = -1; return; }
        int dev = 0, cus = 0, per_cu = 0;
        if (hipGetDevice(&dev) != hipSuccess || hipDeviceGetAttribute(&cus, hipDeviceAttributeMultiprocessorCount, dev) != hipSuccess) { grid = -1; return; }
        if (hipFuncSetAttribute((const void*)fwd_kernel, hipFuncAttributeMaxDynamicSharedMemorySize, LDS_BYTES) != hipSuccess) { fprintf(stderr, "kernel_launch: hipFuncSetAttribute failed\n"); grid = -1; return; }
        if (hipOccupancyMaxActiveBlocksPerMultiprocessor(&per_cu, (const void*)fwd_kernel, NTHR, LDS_BYTES) != hipSuccess || per_cu < 1) fprintf(stderr, "kernel_launch: occupancy query reports %d\n", per_cu);
        (void)hipGetLastError();
        if (cus != 256) { fprintf(stderr, "kernel_launch: built for a 256-CU device (got %d)\n", cus); grid = -1; return; }
        grid = cus;
    }
    if (grid < 0) return;
    (void)hipMemsetAsync((char*)d_ws + WS_CTL, 0, CTL_ZERO_BYTES, stream);
    Args a{};
    for (int i = 0; i < N_IN; ++i) a.in[i] = (const float*)d_in[i];
    a.out = (float*)d_out; a.ws = (unsigned char*)d_ws;
#if MK_ONE_LAUNCH
    a.ph_lo = 0; a.ph_hi = NPH;
    hipLaunchKernelGGL(fwd_kernel, dim3(grid), dim3(NTHR), LDS_BYTES, stream, a);
#else
    for (int p = 0; p < NPH; ++p) { a.ph_lo = p; a.ph_hi = p + 1; hipLaunchKernelGGL(fwd_kernel, dim3(grid), dim3(NTHR), LDS_BYTES, stream, a); }
#endif
}
```

```cpp
#include <hip/hip_runtime.h>
#include <cstdio>
#include <cstdint>
namespace pg8 {
#define PG8_LAS __attribute__((address_space(3)))
typedef unsigned short bf16_t;
typedef short bf16x8 __attribute__((ext_vector_type(8)));
typedef float f32x4 __attribute__((ext_vector_type(4)));
typedef unsigned u32x4 __attribute__((ext_vector_type(4)));
constexpr int BM = 256, BK = 64, HALF = 128, HTB = HALF * BK * 2  , STAGE_BYTES = 8 * HTB, NXCD = 8, WGM = 8;

__host__ __device__ __forceinline__ int lds_byte(int r, int c) { const int st = (r >> 4) * 2 + (c >> 5), rr = r & 15, cc = c & 31, ob = rr * 64 + cc * 2; return st * 1024 + (ob ^ (((ob >> 9) & 1) << 5)); }
__host__ __device__ __forceinline__ void stage_rc(int b, int& R, int& C) { const int st = b / 1024, sb = b % 1024, swz = sb ^ (((sb >> 9) & 1) << 5); R = (st >> 1) * 16 + swz / 64; C = (st & 1) * 32 + (swz % 64) / 2; }
__host__ __device__ __forceinline__ int perm32(int rho) { const int n = rho >> 4, i = rho & 15; return 8 * (i >> 2) + 4 * n + (i & 3); }

struct Unit { int pm, pn; };
struct Gemm { const bf16_t* A; const bf16_t* Bt; int M, N, K; };

struct StaticOrder {
    int nM, nN, nwg, G, c;
    __host__ __device__ void init(int M, int N, int G_, int c_) { nM = M / BM; nN = N / BM; nwg = nM * nN; G = G_; c = c_; }
    __host__ __device__ bool next(int i, Unit& u) const {
        const long L = (long)i * G + c; if (L >= nwg) return false;
        int wgid = (int)L; { const int q = nwg / NXCD, r = nwg % NXCD, xcd = wgid % NXCD, off = wgid / NXCD; wgid = (xcd < r ? xcd * (q + 1) : r * (q + 1) + (xcd - r) * q) + off; }
        const int nig = WGM * nN, gid = wgid / nig, fm = gid * WGM, gsz = (nM - fm) < WGM ? (nM - fm) : WGM;
        u.pm = fm + ((wgid % nig) % gsz); u.pn = (wgid % nig) / gsz; return true;
    }
    __device__ __forceinline__ void a_ready(const Unit&) const {}
    __device__ __forceinline__ void done(const Unit&) const {}
};

typedef float f32x2c __attribute__((ext_vector_type(2))); typedef __bf16 bf16x2c __attribute__((ext_vector_type(2)));
__device__ __forceinline__ unsigned cvt_pk_bf16(float lo, float hi) { const f32x2c v = {lo, hi}; return __builtin_bit_cast(unsigned, __builtin_convertvector(v, bf16x2c)); }
struct EpiF32 {
    static constexpr bool PERM = false, AFTER_DRAIN = false;
    float* C; int ldc;
    __device__ __forceinline__ void operator()(const f32x4 (&acc)[2][2][4][2], const Unit& u, int wr, int wc, int fr, int fq) const {
        const int row0 = u.pm * BM + wr * 64 + fr, col0 = u.pn * BM + wc * 32 + 4 * fq;
#pragma unroll
        for (int ai = 0; ai < 2; ++ai)
#pragma unroll
            for (int m = 0; m < 4; ++m) { float* rowp = C + (size_t)(row0 + ai * HALF + m * 16) * ldc + col0;
#pragma unroll
                for (int bj = 0; bj < 2; ++bj)
#pragma unroll
                    for (int n = 0; n < 2; ++n) *(f32x4*)(rowp + bj * HALF + n * 16) = acc[ai][bj][m][n]; }
    }
};
struct EpiBf16P {
    static constexpr bool PERM = true, AFTER_DRAIN = false;
    bf16_t* O; int ldc;
    __device__ __forceinline__ void operator()(const f32x4 (&acc)[2][2][4][2], const Unit& u, int wr, int wc, int fr, int fq) const {
        const int row0 = u.pm * BM + wr * 64 + fr, col0 = u.pn * BM + wc * 32 + 8 * fq;
#pragma unroll
        for (int ai = 0; ai < 2; ++ai)
#pragma unroll
            for (int m = 0; m < 4; ++m) { bf16_t* rowp = O + (size_t)(row0 + ai * HALF + m * 16) * ldc + col0;
#pragma unroll
                for (int bj = 0; bj < 2; ++bj) { const f32x4 v0 = acc[ai][bj][m][0], v1 = acc[ai][bj][m][1];
                    u32x4 w; w.x = cvt_pk_bf16(v0[0], v0[1]); w.y = cvt_pk_bf16(v0[2], v0[3]); w.z = cvt_pk_bf16(v1[0], v1[1]); w.w = cvt_pk_bf16(v1[2], v1[3]);
                    *(u32x4*)(rowp + bj * HALF) = w; } }
    }
};
struct EpiSwiGLU {
    static constexpr bool PERM = true, AFTER_DRAIN = false;
    bf16_t* O; int ldc;
    __device__ __forceinline__ static float silu_mul(float g, float u) { return g * u * __builtin_amdgcn_rcpf(1.0f + __builtin_amdgcn_exp2f(-1.44269504089f * g)); }
    __device__ __forceinline__ void operator()(const f32x4 (&acc)[2][2][4][2], const Unit& u, int wr, int wc, int fr, int fq) const {
        const int row0 = u.pm * BM + wr * 64 + fr, col0 = u.pn * HALF + wc * 32 + 8 * fq;
#pragma unroll
        for (int ai = 0; ai < 2; ++ai)
#pragma unroll
            for (int m = 0; m < 4; ++m) { bf16_t* rowp = O + (size_t)(row0 + ai * HALF + m * 16) * ldc + col0;
                const f32x4 g0 = acc[ai][0][m][0], g1 = acc[ai][0][m][1], u0 = acc[ai][1][m][0], u1 = acc[ai][1][m][1];
                u32x4 w; w.x = cvt_pk_bf16(silu_mul(g0[0], u0[0]), silu_mul(g0[1], u0[1])); w.y = cvt_pk_bf16(silu_mul(g0[2], u0[2]), silu_mul(g0[3], u0[3]));
                w.z = cvt_pk_bf16(silu_mul(g1[0], u1[0]), silu_mul(g1[1], u1[1])); w.w = cvt_pk_bf16(silu_mul(g1[2], u1[2]), silu_mul(g1[3], u1[3]));
                *(u32x4*)rowp = w; }
    }
};

template <class Epi, class Sched, bool ALIGN_EPI = false, bool SP2 = false>
__device__ __forceinline__ void gemm_phase(PG8_LAS unsigned char* lds, const Gemm g, const Sched& S, const Epi& E, int tid_in) {
    const int tid = tid_in, wid = __builtin_amdgcn_readfirstlane(tid >> 6), lane = tid & 63, wr = wid >> 2, wc = wid & 3, fr = lane & 15, fq = lane >> 4;
    const int K = g.K, nt = K / BK;
    unsigned voffA[2], voffB[2];
#pragma unroll
    for (int i = 0; i < 2; ++i) { int R, C; stage_rc(tid * 16 + i * 8192, R, C); const int Rb = Epi::PERM ? ((R & ~31) + perm32(R & 31)) : R;
        voffA[i] = (unsigned)(R * K + C) * 2u; voffB[i] = (unsigned)(Rb * K + C) * 2u; }
    const size_t kstep = (size_t)(BK * 2);
    const size_t hstep = (size_t)HALF * K * 2;
    const size_t tstep = 2 * hstep;
    const unsigned ldsw = (unsigned)wid * 1024u;
    const int aoff = lds_byte(wr * 64 + fr, fq * 8), boff = lds_byte(wc * 32 + fr, fq * 8);
#define PG8_SA(b, h) (((b) * 2 + (h)) * HTB)
#define PG8_SB(b, h) ((4 + (b) * 2 + (h)) * HTB)
#define PG8_STAGE(bufoff, gbase, voff) do { _Pragma("unroll") for (int _i = 0; _i < 2; ++_i) \
        __builtin_amdgcn_global_load_lds((const unsigned*)((const char*)(gbase) + (voff)[_i]), (PG8_LAS unsigned*)(lds + (bufoff) + ldsw + _i * 8192), 16, 0, 0); } while (0)
#define PG8_LDA(dst, b, h) do { _Pragma("unroll") for (int m = 0; m < 4; ++m) _Pragma("unroll") for (int k = 0; k < 2; ++k) dst[m][k] = *(const PG8_LAS bf16x8*)(lds + PG8_SA(b, h) + aoff + m * 2048 + k * 1024); } while (0)
#define PG8_LDB(dst, b, h) do { _Pragma("unroll") for (int n = 0; n < 2; ++n) _Pragma("unroll") for (int k = 0; k < 2; ++k) dst[n][k] = *(const PG8_LAS bf16x8*)(lds + PG8_SB(b, h) + boff + n * 2048 + k * 1024); } while (0)
#define PG8_MMA(ai, bj, At, Bt) do { __builtin_amdgcn_s_setprio(1); _Pragma("unroll") for (int m = 0; m < 4; ++m) _Pragma("unroll") for (int n = 0; n < 2; ++n) _Pragma("unroll") for (int k = 0; k < 2; ++k) \
        acc[ai][bj][m][n] = __builtin_amdgcn_mfma_f32_16x16x32_bf16(Bt[n][k], At[m][k], acc[ai][bj][m][n], 0, 0, 0); __builtin_amdgcn_s_setprio(0); } while (0)
#define PG8_WAIT_V(n) asm volatile("s_waitcnt vmcnt(" #n ")" ::: "memory")
#define PG8_WAIT_L(n) asm volatile("s_waitcnt lgkmcnt(" #n ")" ::: "memory")
#define PG8_BAR __builtin_amdgcn_s_barrier()
#define PG8_SCHED __builtin_amdgcn_sched_barrier(0)
    Unit cur, nxt; int ui = 0;
    if (!S.next(0, cur)) return;
    f32x4 acc[2][2][4][2];
#pragma unroll
    for (int a = 0; a < 2; ++a)
#pragma unroll
        for (int b = 0; b < 2; ++b)
#pragma unroll
            for (int m = 0; m < 4; ++m)
#pragma unroll
                for (int n = 0; n < 2; ++n) acc[a][b][m][n] = (f32x4){0.f, 0.f, 0.f, 0.f};
    bf16x8 At[4][2], B0[2][2], B1[2][2];
    const char* cA = (const char*)g.A + (size_t)cur.pm * tstep; const char* cB = (const char*)g.Bt + (size_t)cur.pn * tstep;
    S.a_ready(cur);
    if constexpr (SP2) {
        PG8_STAGE(PG8_SB(0, 0), cB, voffB); PG8_STAGE(PG8_SB(0, 1), cB + hstep, voffB); PG8_STAGE(PG8_SA(0, 0), cA, voffA); PG8_STAGE(PG8_SA(0, 1), cA + hstep, voffA);
        if (wr == 1) PG8_BAR;
        PG8_WAIT_V(2); PG8_BAR;
        PG8_STAGE(PG8_SB(1, 0), cB + kstep, voffB); PG8_STAGE(PG8_SA(1, 0), cA + kstep, voffA); PG8_STAGE(PG8_SB(1, 1), cB + hstep + kstep, voffB);
        PG8_WAIT_V(6); PG8_BAR;
    } else {
        PG8_STAGE(PG8_SB(0, 0), cB, voffB); PG8_STAGE(PG8_SA(0, 0), cA, voffA); PG8_STAGE(PG8_SB(0, 1), cB + hstep, voffB); PG8_STAGE(PG8_SA(0, 1), cA + hstep, voffA);
        if (wr == 1) PG8_BAR;
        PG8_WAIT_V(4); PG8_BAR;
        PG8_STAGE(PG8_SB(1, 0), cB + kstep, voffB); PG8_STAGE(PG8_SA(1, 0), cA + kstep, voffA); PG8_STAGE(PG8_SB(1, 1), cB + hstep + kstep, voffB);
        PG8_WAIT_V(6); PG8_BAR;
    }
    for (;;) {
        const bool has_next = S.next(ui + 1, nxt);
        const char* nA = has_next ? (const char*)g.A + (size_t)nxt.pm * tstep : cA; const char* nB = has_next ? (const char*)g.Bt + (size_t)nxt.pn * tstep : cB;
        for (int t = 0; t < nt; t += 2) {
            const bool last = (t == nt - 2);
            const char* a1 = cA + (size_t)(t + 1) * kstep;
            const char* a2 = last ? nA : cA + (size_t)(t + 2) * kstep; const char* b2 = last ? nB : cB + (size_t)(t + 2) * kstep;
            const char* a3 = a2 + kstep; const char* b3 = b2 + kstep;
            if (last && has_next) S.a_ready(nxt);
            if constexpr (SP2) {
            PG8_LDB(B0, 0, 0); PG8_LDB(B1, 0, 1); PG8_SCHED; PG8_LDA(At, 0, 0); PG8_STAGE(PG8_SA(1, 1), a1 + hstep, voffA);
            PG8_WAIT_V(8); PG8_WAIT_L(0); PG8_BAR; PG8_MMA(0, 0, At, B0); PG8_MMA(0, 1, At, B1); PG8_BAR; PG8_SCHED;
            PG8_LDA(At, 0, 1); PG8_STAGE(PG8_SB(0, 0), b2, voffB); PG8_STAGE(PG8_SB(0, 1), b2 + hstep, voffB); PG8_STAGE(PG8_SA(0, 0), a2, voffA);
            PG8_WAIT_V(8); PG8_WAIT_L(0); PG8_BAR; PG8_MMA(1, 0, At, B0); PG8_MMA(1, 1, At, B1); PG8_BAR; PG8_SCHED;
            PG8_LDB(B0, 1, 0); PG8_LDB(B1, 1, 1); PG8_SCHED; PG8_LDA(At, 1, 0); PG8_STAGE(PG8_SA(0, 1), a2 + hstep, voffA);
            PG8_WAIT_V(8); PG8_WAIT_L(0); PG8_BAR; PG8_MMA(0, 0, At, B0); PG8_MMA(0, 1, At, B1); PG8_BAR; PG8_SCHED;
            PG8_LDA(At, 1, 1); PG8_STAGE(PG8_SB(1, 0), b3, voffB); PG8_STAGE(PG8_SB(1, 1), b3 + hstep, voffB); PG8_STAGE(PG8_SA(1, 0), a3, voffA);
            PG8_WAIT_V(8); PG8_WAIT_L(0); PG8_BAR; PG8_MMA(1, 0, At, B0); PG8_MMA(1, 1, At, B1); PG8_BAR; PG8_SCHED;
            } else {
            PG8_LDB(B0, 0, 0); PG8_SCHED; PG8_LDA(At, 0, 0); PG8_STAGE(PG8_SA(1, 1), a1 + hstep, voffA);
            PG8_WAIT_L(8); PG8_BAR; PG8_WAIT_L(0); PG8_MMA(0, 0, At, B0); PG8_BAR; PG8_SCHED;
            PG8_LDB(B1, 0, 1); PG8_STAGE(PG8_SB(0, 0), b2, voffB);
            PG8_BAR; PG8_WAIT_L(0); PG8_MMA(0, 1, At, B1); PG8_BAR;
            PG8_LDA(At, 0, 1); PG8_STAGE(PG8_SA(0, 0), a2, voffA);
            PG8_BAR; PG8_WAIT_L(0); PG8_MMA(1, 0, At, B0); PG8_BAR; PG8_SCHED;
            PG8_STAGE(PG8_SB(0, 1), b2 + hstep, voffB);
            PG8_WAIT_V(6); PG8_BAR; PG8_MMA(1, 1, At, B1); PG8_BAR;
            PG8_LDB(B0, 1, 0); PG8_SCHED; PG8_LDA(At, 1, 0); PG8_STAGE(PG8_SA(0, 1), a2 + hstep, voffA);
            PG8_WAIT_L(8); PG8_BAR; PG8_WAIT_L(0); PG8_MMA(0, 0, At, B0); PG8_BAR; PG8_SCHED;
            PG8_LDB(B1, 1, 1); PG8_STAGE(PG8_SB(1, 0), b3, voffB);
            PG8_BAR; PG8_WAIT_L(0); PG8_MMA(0, 1, At, B1); PG8_BAR;
            PG8_LDA(At, 1, 1); PG8_STAGE(PG8_SA(1, 0), a3, voffA);
            PG8_BAR; PG8_WAIT_L(0); PG8_MMA(1, 0, At, B0); PG8_BAR; PG8_SCHED;
            PG8_STAGE(PG8_SB(1, 1), b3 + hstep, voffB);
            PG8_WAIT_V(6); PG8_BAR; PG8_MMA(1, 1, At, B1); PG8_BAR;
            }
        }
        if constexpr (ALIGN_EPI) { if (wr == 0) PG8_BAR; }
        if constexpr (!Epi::AFTER_DRAIN) { E(acc, cur, wr, wc, fr, fq); S.done(cur); }
        if (!has_next) break;
#pragma unroll
        for (int a = 0; a < 2; ++a)
#pragma unroll
            for (int b = 0; b < 2; ++b)
#pragma unroll
                for (int m = 0; m < 4; ++m)
#pragma unroll
                    for (int n = 0; n < 2; ++n) acc[a][b][m][n] = (f32x4){0.f, 0.f, 0.f, 0.f};
        cur = nxt; cA = nA; cB = nB; ++ui;
        if constexpr (ALIGN_EPI) { if (wr == 1) PG8_BAR; }
    }
    PG8_WAIT_V(0);
    if constexpr (!ALIGN_EPI) { if (wr == 0) PG8_BAR; }
    PG8_BAR;
    if constexpr (Epi::AFTER_DRAIN) { E.fused(acc, cur, wr, wc, fr, fq, lds, wid, lane); S.done(cur); }
#undef PG8_SA
#undef PG8_SB
#undef PG8_STAGE
#undef PG8_LDA
#undef PG8_LDB
#undef PG8_MMA
#undef PG8_WAIT_V
#undef PG8_WAIT_L
#undef PG8_BAR
#undef PG8_SCHED
}
}

#define LAS __attribute__((address_space(3)))
typedef unsigned short bf16_t;
typedef float f32x4 __attribute__((ext_vector_type(4)));
typedef float f32x2 __attribute__((ext_vector_type(2)));
typedef unsigned u32x4 __attribute__((ext_vector_type(4)));
typedef unsigned u32x2 __attribute__((ext_vector_type(2)));
constexpr int NWAVES = 8, NTHR = 512;
constexpr int D = 2048, SEQ = 4096, M = 8192, DEPTH = 4, DFF = 5632, NGU = 2 * DFF, NIN = 5900, NINP = 6144;
constexpr int PC_SSM = 0, PC_AQ = 512, PC_AK = 1280, PC_AV = 2048, PC_DQKV = 2816, PC_DZ = 5120, PC_DA = 5888, PC_DB = 5894;
constexpr float EPS = 1e-6f;
enum { I_X = 0, I_GAINS, I_WG, I_WU, I_WD, I_WIN, I_WOUT, I_LRE, I_LIM, I_BRE, I_BIM, I_CRE, I_CIM, I_SD, I_LOGDT, I_GLUW, I_GLUB, I_SGAIN, I_CONVW, I_ALOG, I_DTB, I_DNG, I_ATG, I_RELB, N_IN };
constexpr size_t MiB = 1ull << 20;
constexpr size_t WS_CTL = 0, CTL_ZERO_BYTES = 1 * MiB;
constexpr size_t WS_WGU = 1 * MiB;
constexpr size_t WS_WD = WS_WGU + 352 * MiB;
constexpr size_t WS_WIN = WS_WD + 176 * MiB;
constexpr size_t WS_WOUT = WS_WIN + 96 * MiB;
constexpr size_t WS_WGLU = WS_WOUT + 32 * MiB;
constexpr size_t WS_X = WS_WGLU + 2 * MiB;
constexpr size_t WS_H = WS_X + 64 * MiB;
constexpr size_t WS_ACT = WS_H + 32 * MiB;
constexpr size_t WS_Y = WS_ACT + 88 * MiB;
constexpr size_t WS_PROJ = WS_Y + 64 * MiB;
constexpr size_t WS_MIX = WS_PROJ + 192 * MiB;
constexpr size_t WS_SSME = WS_MIX + 32 * MiB;
constexpr size_t WS_YG = WS_SSME + 2 * MiB;
constexpr size_t WS_YGB = WS_YG + 16 * MiB;
constexpr size_t WS_Z = WS_YGB + 8 * MiB;
constexpr size_t WS_DQ = WS_Z + 16 * MiB;
constexpr size_t WS_DK = WS_DQ + 24 * MiB;
constexpr size_t WS_DV = WS_DK + 24 * MiB;
constexpr size_t WS_DO = WS_DV + 24 * MiB;
constexpr size_t WS_DBG = WS_DO + 24 * MiB;
constexpr size_t WS_DWN = WS_DQ;
constexpr size_t WS_DQD = WS_DWN + 12 * MiB;
constexpr size_t WS_DKT = WS_DQD + 12 * MiB;
constexpr size_t WS_DAT = WS_DKT + 12 * MiB;
constexpr size_t WS_DUD = WS_DAT + 6 * MiB;
constexpr size_t WS_DCD = WS_DUD + 24 * MiB;
static_assert(WS_DCD + 1 * MiB <= WS_DO, "DN overlay");
constexpr size_t WS_AO = WS_DBG + 1 * MiB;
constexpr size_t WS_ALSE = WS_AO + 72 * MiB;
constexpr size_t WS_DSS = WS_ALSE + 1 * MiB;
constexpr size_t WS_DVN = WS_DSS + 24 * MiB;
constexpr size_t WS_END = WS_DVN + 12 * MiB;
constexpr int CW_BAR = 4096;
constexpr int LDS_BYTES = 155648, MISC_OFF = LDS_BYTES - 256;

#define XB_TMO      128
#define XB_XCNT(j)  (256  + 64 * (j))
#define XB_XSUB(j)  (1280 + 64 * (j))
#define XB_XGEN(j)  (2304 + 64 * (j))
#define XB_TOP      3328
#define XB_TOPGEN   3392
#define XCD_BAR_WORDS 3456
#define XB_SPIN_CAP (1u << 18)

__device__ __forceinline__ unsigned xb_ld(unsigned* p)              { return __hip_atomic_load(p, __ATOMIC_RELAXED, __HIP_MEMORY_SCOPE_AGENT); }
__device__ __forceinline__ unsigned xb_add(unsigned* p, unsigned v) { return __hip_atomic_fetch_add(p, v, __ATOMIC_RELAXED, __HIP_MEMORY_SCOPE_AGENT); }
__device__ __forceinline__ unsigned xb_xcc_id() { return (unsigned)__builtin_amdgcn_s_getreg((3 << 11) | 20) & 0xFu; }
#define XB_SPIN(cond, bar) do { unsigned _sp = 0; while (cond) { __builtin_amdgcn_s_sleep(1); \
    if ((++_sp & 255u) == 0u) { if (xb_ld(&(bar)[XB_TMO])) break; if (_sp > XB_SPIN_CAP) { atomicAdd(&(bar)[XB_TMO], 1u); break; } } } } while (0)

struct XcdBarrier {
    unsigned* bar; unsigned x;
    volatile LAS unsigned* st;
};

__device__ __forceinline__ XcdBarrier xcd_barrier_post(unsigned* bar, volatile LAS unsigned* st) {
    XcdBarrier b; b.bar = bar; b.x = xb_xcc_id(); b.st = st;
    if (threadIdx.x == 0) (void)xb_add(&bar[XB_XCNT(b.x)], 1u);
    return b;
}
__device__ __forceinline__ void xcd_barrier_complete(unsigned* bar, unsigned x, unsigned& nloc, unsigned& nx) {
    const unsigned G = gridDim.x * gridDim.y * gridDim.z;
    unsigned sum, cnt, mine, sp = 0u;
    for (;;) {
        sum = 0u; cnt = 0u; mine = 0u;
#pragma unroll
        for (unsigned j = 0; j < 16; ++j) { const unsigned c = xb_ld(&bar[XB_XCNT(j)]); sum += c; cnt += (c > 0u) ? 1u : 0u; mine = (j == x) ? c : mine; }
        if (sum == G) break;
        __builtin_amdgcn_s_sleep(1);
        if ((++sp & 255u) == 0u) { if (xb_ld(&bar[XB_TMO])) break; if (sp > XB_SPIN_CAP) { atomicAdd(&bar[XB_TMO], 1u); break; } }
    }
    nloc = mine > 0u ? mine : 1u; nx = cnt > 0u ? cnt : 1u;
}

__device__ __forceinline__ void xcd_barrier(const XcdBarrier& b) {
    asm volatile("s_waitcnt vmcnt(0)" ::: "memory");
    __syncthreads();
    if (threadIdx.x == 0) {
        unsigned bz_ = 0; asm volatile("" : "+s"(bz_)); unsigned* bar = b.bar + bz_;
        __builtin_amdgcn_s_waitcnt(0);
        unsigned nloc = b.st[0], nx = b.st[1];
        if (nloc == 0u) { xcd_barrier_complete(bar, b.x, nloc, nx); b.st[0] = nloc; b.st[1] = nx; }
        const unsigned old = xb_add(&bar[XB_XSUB(b.x)], 1u);
        const unsigned gen = old / nloc;
        if (old + 1u == (gen + 1u) * nloc) {
            __builtin_amdgcn_fence(__ATOMIC_RELEASE, "agent");
            asm volatile("s_waitcnt vmcnt(0)" ::: "memory");
            const unsigned og = xb_add(&bar[XB_TOP], 1u);
            const unsigned tg = og / nx;
            if (og + 1u == (tg + 1u) * nx) xb_add(&bar[XB_TOPGEN], 1u);
            else XB_SPIN(xb_ld(&bar[XB_TOPGEN]) == tg, bar);
            __builtin_amdgcn_fence(__ATOMIC_ACQUIRE, "agent");
            xb_add(&bar[XB_XGEN(b.x)], 1u);
            asm volatile("s_waitcnt vmcnt(0)" ::: "memory");
        } else {
            XB_SPIN(xb_ld(&bar[XB_XGEN(b.x)]) == gen, bar);
            __builtin_amdgcn_fence(__ATOMIC_ACQUIRE, "agent");
            asm volatile("s_waitcnt vmcnt(0)" ::: "memory");
        }
    }
    __syncthreads();
}

struct Args { const float* in[24]; float* out; unsigned char* ws; int ph_lo, ph_hi; };
__device__ __forceinline__ float shx(int lane, float v, int o) { return __int_as_float(__builtin_amdgcn_ds_bpermute((lane ^ o) << 2, __float_as_int(v))); }
__device__ __forceinline__ float wave_sum(int lane, float v) {
#pragma unroll
    for (int o = 1; o < 64; o <<= 1) v += shx(lane, v, o);
    return v;
}
__device__ __forceinline__ float wave_max(int lane, float v) {
#pragma unroll
    for (int o = 1; o < 64; o <<= 1) v = fmaxf(v, shx(lane, v, o));
    return v;
}
__device__ __forceinline__ unsigned pk2(float lo, float hi) { return pg8::cvt_pk_bf16(lo, hi); }
__device__ __forceinline__ f32x4 zero_acc() { float z = 0.f; asm volatile("" : "+v"(z)); return (f32x4){z, z, z, z}; }
__device__ __forceinline__ float bf_lo(unsigned w) { return __uint_as_float(w << 16); }
__device__ __forceinline__ float bf_hi(unsigned w) { return __uint_as_float(w & 0xffff0000u); }
__device__ __forceinline__ float sigmoidf_(float x) { return 1.0f / (1.0f + expf(-x)); }
__device__ __forceinline__ float siluf_(float x) { return x / (1.0f + expf(-x)); }
#define LDS_WAIT() asm volatile("s_waitcnt lgkmcnt(0)" ::: "memory")

struct CvItem { const float* src; bf16_t* dst; int ldw, K, nvalid; };
__device__ __forceinline__ void cv_load(const CvItem& d, f32x4 (&r)[8], int lane) {
    if (d.nvalid == 32) { const int c4 = lane & 7, kr = lane >> 3;
#pragma unroll
        for (int i = 0; i < 8; ++i) r[i] = *(const f32x4*)(d.src + (size_t)(8 * i + kr) * d.ldw + 4 * c4); }
}
__device__ __forceinline__ void cv_finish(const CvItem& d, const f32x4 (&r)[8], LAS float* scr, int lane) {
    if (d.nvalid == 32) { const int c4 = lane & 7, kr = lane >> 3;
#pragma unroll
        for (int i = 0; i < 8; ++i) { const int kk = 8 * i + kr; scr[kk * 33 + 4 * c4] = r[i].x; scr[kk * 33 + 4 * c4 + 1] = r[i].y; scr[kk * 33 + 4 * c4 + 2] = r[i].z; scr[kk * 33 + 4 * c4 + 3] = r[i].w; } }
    else { const int c = lane & 31;
#pragma unroll 8
        for (int i = 0; i < 32; ++i) { const int kk = 2 * i + (lane >> 5); scr[kk * 33 + c] = (c < d.nvalid) ? d.src[(size_t)kk * d.ldw + c] : 0.f; } }
    LDS_WAIT(); asm volatile("" ::: "memory");
    const int c8 = lane & 7;
#pragma unroll
    for (int j = 0; j < 4; ++j) { const int n = (lane >> 3) + 8 * j; const LAS float* s = scr + (8 * c8) * 33 + n;
        u32x4 o; o.x = pk2(s[0 * 33], s[1 * 33]); o.y = pk2(s[2 * 33], s[3 * 33]); o.z = pk2(s[4 * 33], s[5 * 33]); o.w = pk2(s[6 * 33], s[7 * 33]);
        *(u32x4*)(d.dst + (size_t)n * d.K + 8 * c8) = o; }
    LDS_WAIT(); asm volatile("" ::: "memory");
}
__device__ __forceinline__ void rmsnorm_row_bf16(const float* xrow, const float* gain, bf16_t* orow, int lane) {
    f32x4 v[8]; float ss = 0.f;
#pragma unroll
    for (int j = 0; j < 8; ++j) { v[j] = ((const f32x4*)xrow)[lane + 64 * j]; ss += (v[j].x * v[j].x + v[j].y * v[j].y) + (v[j].z * v[j].z + v[j].w * v[j].w); }
    const float r = rsqrtf(wave_sum(lane, ss) * (1.f / D) + EPS);
#pragma unroll
    for (int j = 0; j < 8; ++j) { const f32x4 g = ((const f32x4*)gain)[lane + 64 * j]; u32x2 w; w.x = pk2(v[j].x * r * g.x, v[j].y * r * g.y); w.y = pk2(v[j].z * r * g.z, v[j].w * r * g.w);
        ((u32x2*)orow)[lane + 64 * j] = w; }
}
constexpr int CV_GU = 2 * 352 * 32, CV_D = 2 * 64 * 88, CV_IN = 192 * 32, CV_OUT = 64 * 32, CV_GLU = 16 * 8, CV_ITEMS = CV_GU + CV_D + CV_IN + CV_OUT + CV_GLU;
__device__ __forceinline__ CvItem cv_decode(const Args& a, unsigned char* ws, int L, int it) {
    int r = it; CvItem d;
    if (r < CV_GU) { const int mi = L * 2 + r / (352 * 32), q = r % (352 * 32), kb = q / 352, ng = q % 352, nd0 = 32 * ng, pn = nd0 >> 8, wi = nd0 & 255, bj = wi >> 7, i = wi & 127;
        d.src = (bj ? a.in[I_WU] : a.in[I_WG]) + (size_t)mi * D * DFF + (size_t)(64 * kb) * DFF + 128 * pn + i; d.ldw = DFF; d.nvalid = 32;
        d.dst = (bf16_t*)(ws + WS_WGU) + (size_t)mi * NGU * D + (size_t)nd0 * D + 64 * kb; d.K = D; return d; }
    r -= CV_GU;
    if (r < CV_D) { const int mi = L * 2 + r / (64 * 88), q = r % (64 * 88), kb = q / 64, ng = q % 64;
        d.src = a.in[I_WD] + (size_t)mi * DFF * D + (size_t)(64 * kb) * D + 32 * ng; d.ldw = D; d.nvalid = 32;
        d.dst = (bf16_t*)(ws + WS_WD) + (size_t)mi * D * DFF + (size_t)(32 * ng) * DFF + 64 * kb; d.K = DFF; return d; }
    r -= CV_D;
    if (r < CV_IN) { const int kb = r / 192, ng = r % 192; int nv = NIN - 32 * ng; nv = nv > 32 ? 32 : (nv < 0 ? 0 : nv);
        d.src = a.in[I_WIN] + (size_t)L * D * NIN + (size_t)(64 * kb) * NIN + 32 * ng; d.ldw = NIN; d.nvalid = nv;
        d.dst = (bf16_t*)(ws + WS_WIN) + (size_t)L * NINP * D + (size_t)(32 * ng) * D + 64 * kb; d.K = D; return d; }
    r -= CV_IN;
    if (r < CV_OUT) { const int kb = r / 64, ng = r % 64;
        d.src = a.in[I_WOUT] + (size_t)L * D * D + (size_t)(64 * kb) * D + 32 * ng; d.ldw = D; d.nvalid = 32;
        d.dst = (bf16_t*)(ws + WS_WOUT) + (size_t)L * D * D + (size_t)(32 * ng) * D + 64 * kb; d.K = D; return d; }
    r -= CV_OUT;
    { const int kb = r / 16, ng = r % 16;
        d.src = a.in[I_GLUW] + (size_t)L * 512 * 512 + (size_t)(64 * kb) * 512 + 32 * ng; d.ldw = 512; d.nvalid = 32;
        d.dst = (bf16_t*)(ws + WS_WGLU) + (size_t)L * 512 * 512 + (size_t)(32 * ng) * 512 + 64 * kb; d.K = 512; return d; }
}
__device__ __forceinline__ void cv_run(const Args& a, unsigned char* ws, int L, int first, int stride, int count, LAS float* scr, int lane) {
    if (count <= 0 || first >= CV_ITEMS) return;
    CvItem cur = cv_decode(a, ws, L, first); f32x4 r0[8], r1[8];
    cv_load(cur, r0, lane);
    for (int j = 0; j < count; ++j) {
        const int nit = first + (j + 1) * stride; const bool more = (j + 1 < count) && (nit < CV_ITEMS);
        CvItem nx = cur;
        if (more) { nx = cv_decode(a, ws, L, nit); cv_load(nx, r1, lane); }
        cv_finish(cur, r0, scr, lane);
        if (!more) break;
        cur = nx;
#pragma unroll
        for (int i = 0; i < 8; ++i) r0[i] = r1[i];
    }
}
__device__ __forceinline__ void p0_prologue(const Args& a, unsigned char* ws, LAS unsigned char* lds, int blk, int G, int tid) {
    const int lane = tid & 63, wave = __builtin_amdgcn_readfirstlane(tid >> 6), gw = blk * NWAVES + wave, ngw = G * NWAVES;
    LAS float* scr = (LAS float*)(lds + wave * 16384);
    cv_run(a, ws, 0, gw, ngw, (CV_ITEMS + ngw - 1) / ngw, scr, lane);
    for (int m = gw; m < M; m += ngw) rmsnorm_row_bf16(a.in[I_X] + (size_t)m * D, a.in[I_GAINS], (bf16_t*)(ws + WS_H) + (size_t)m * D, lane);
}
constexpr int CW_Q = 8192, CW_DONE = 8192 + 64 * 8;
__device__ __forceinline__ void conv_slot(const Args& a, unsigned char* ws, int L, int slot, unsigned target, LAS unsigned char* lds, volatile LAS unsigned* MISC, int tid) {
    if (L >= DEPTH) return;
    const int lane = tid & 63, wave = __builtin_amdgcn_readfirstlane(tid >> 6);
    unsigned* q = (unsigned*)(ws + WS_CTL) + CW_Q + 64 * L; unsigned* dn = (unsigned*)(ws + WS_CTL) + CW_DONE + 64 * slot;
    LAS float* scr = (LAS float*)(lds + wave * 16384);
    __syncthreads();
    if (target && tid == 0) __hip_atomic_fetch_add(dn, 1u, __ATOMIC_RELAXED, __HIP_MEMORY_SCOPE_AGENT);
    const unsigned nb = target ? 2u : 8u;
    for (;;) {
        if (tid == 0) { unsigned base = 0xffffffffu;
            if (!target || __hip_atomic_load(dn, __ATOMIC_RELAXED, __HIP_MEMORY_SCOPE_AGENT) < target) base = __hip_atomic_fetch_add(q, 8u * nb, __ATOMIC_RELAXED, __HIP_MEMORY_SCOPE_AGENT);
            MISC[16] = base; }
        __syncthreads();
        const unsigned base = MISC[16];
        __syncthreads();
        if (base >= (unsigned)CV_ITEMS) break;
        cv_run(a, ws, L, (int)base + wave, 8, (int)nb, scr, lane);
    }
}

__device__ __forceinline__ void bf8_to_f32(const u32x4 w, float (&o)[8]) { o[0] = bf_lo(w.x); o[1] = bf_hi(w.x); o[2] = bf_lo(w.y); o[3] = bf_hi(w.y); o[4] = bf_lo(w.z); o[5] = bf_hi(w.z); o[6] = bf_lo(w.w); o[7] = bf_hi(w.w); }
template <bool SRC_F32, bool DST_F32>
__device__ __forceinline__ void thin_phase(const void* xsrc, void* xdst, const bf16_t* y, const float* gpost, float scale, const float* gpre, bf16_t* h, int blk, int G, int tid) {
    const int lane = tid & 63, wave = __builtin_amdgcn_readfirstlane(tid >> 6), gw = blk * NWAVES + wave, ngw = G * NWAVES;
    for (int m = gw; m < M; m += ngw) {
        float yv[4][8], xv[4][8]; float ss = 0.f;
#pragma unroll
        for (int j = 0; j < 4; ++j) { bf8_to_f32(((const u32x4*)(y + (size_t)m * D))[lane + 64 * j], yv[j]);
            if (SRC_F32) { const f32x4 a0 = ((const f32x4*)((const float*)xsrc + (size_t)m * D))[(lane + 64 * j) * 2], a1 = ((const f32x4*)((const float*)xsrc + (size_t)m * D))[(lane + 64 * j) * 2 + 1];
                xv[j][0] = a0.x; xv[j][1] = a0.y; xv[j][2] = a0.z; xv[j][3] = a0.w; xv[j][4] = a1.x; xv[j][5] = a1.y; xv[j][6] = a1.z; xv[j][7] = a1.w; }
            else bf8_to_f32(((const u32x4*)((const bf16_t*)xsrc + (size_t)m * D))[lane + 64 * j], xv[j]);
#pragma unroll
            for (int i = 0; i < 8; ++i) ss += yv[j][i] * yv[j][i]; }
        const float r1 = rsqrtf(wave_sum(lane, ss) * (1.f / D) + EPS) * scale; float s2 = 0.f;
#pragma unroll
        for (int j = 0; j < 4; ++j) { const f32x4 g0 = ((const f32x4*)gpost)[(lane + 64 * j) * 2], g1 = ((const f32x4*)gpost)[(lane + 64 * j) * 2 + 1]; const float gg[8] = {g0.x, g0.y, g0.z, g0.w, g1.x, g1.y, g1.z, g1.w};
#pragma unroll
            for (int i = 0; i < 8; ++i) { xv[j][i] += yv[j][i] * r1 * gg[i]; s2 += xv[j][i] * xv[j][i]; }
            if (DST_F32) { ((f32x4*)((float*)xdst + (size_t)m * D))[(lane + 64 * j) * 2] = (f32x4){xv[j][0], xv[j][1], xv[j][2], xv[j][3]}; ((f32x4*)((float*)xdst + (size_t)m * D))[(lane + 64 * j) * 2 + 1] = (f32x4){xv[j][4], xv[j][5], xv[j][6], xv[j][7]}; }
            else { u32x4 w; w.x = pk2(xv[j][0], xv[j][1]); w.y = pk2(xv[j][2], xv[j][3]); w.z = pk2(xv[j][4], xv[j][5]); w.w = pk2(xv[j][6], xv[j][7]); ((u32x4*)((bf16_t*)xdst + (size_t)m * D))[lane + 64 * j] = w; } }
        if (h) { const float r2 = rsqrtf(wave_sum(lane, s2) * (1.f / D) + EPS);
#pragma unroll
            for (int j = 0; j < 4; ++j) { const f32x4 g0 = ((const f32x4*)gpre)[(lane + 64 * j) * 2], g1 = ((const f32x4*)gpre)[(lane + 64 * j) * 2 + 1];
                u32x4 w; w.x = pk2(xv[j][0] * r2 * g0.x, xv[j][1] * r2 * g0.y); w.y = pk2(xv[j][2] * r2 * g0.z, xv[j][3] * r2 * g0.w); w.z = pk2(xv[j][4] * r2 * g1.x, xv[j][5] * r2 * g1.y); w.w = pk2(xv[j][6] * r2 * g1.z, xv[j][7] * r2 * g1.w);
                ((u32x4*)(h + (size_t)m * D))[lane + 64 * j] = w; } }
    }
}

__device__ __forceinline__ void ssm_lambda(const Args& a, int l, int g, int p, float& ar, float& ai, float& cr, float& ci) {
    const float lr = a.in[I_LRE][(l * 32 + g) * 64 + p], li = a.in[I_LIM][(l * 32 + g) * 64 + p], dt = expf(a.in[I_LOGDT][l * 32 + g]);
    const float x = lr * dt, yy = li * dt; float sn, cs; sincosf(yy, &sn, &cs); const float mag = expf(x);
    ar = mag * cs; ai = mag * sn;
    const float sh = sinf(0.5f * yy); const float er = expm1f(x) * cs - 2.f * sh * sh, ei = ai;
    const float den = 1.f / (lr * lr + li * li); cr = (er * lr + ei * li) * den; ci = (ei * lr - er * li) * den;
}
__device__ __forceinline__ void ssm_local(const Args& a, unsigned char* ws, int l, int blk, int G, int tid, LAS unsigned char* lds) {
    const int lane = tid & 63, wave = __builtin_amdgcn_readfirstlane(tid >> 6), gw = blk * NWAVES + wave, ngw = G * NWAVES;
    const bf16_t* proj = (const bf16_t*)(ws + WS_PROJ); f32x2* E = (f32x2*)(ws + WS_SSME);
    LAS f32x4* ubuf = (LAS f32x4*)(lds + wave * 4096);
    for (int wu = gw; wu < 4096; wu += ngw) {
        const int b = wu >> 11, g = (wu >> 6) & 31, ch = wu & 63;
        const bf16_t* up = proj + (size_t)(b * SEQ + ch * 64) * NINP + PC_SSM + g * 16;
        const u32x4 ub0 = *(const u32x4*)(up + (size_t)lane * NINP), ub1 = *(const u32x4*)(up + (size_t)lane * NINP + 8);
        float ar, ai, cr, ci; ssm_lambda(a, l, g, lane, ar, ai, cr, ci);
        float bbr[16], bbi[16];
        { const f32x4* br = (const f32x4*)(a.in[I_BRE] + ((size_t)(l * 32 + g) * 64 + lane) * 16); const f32x4* bi = (const f32x4*)(a.in[I_BIM] + ((size_t)(l * 32 + g) * 64 + lane) * 16);
#pragma unroll
          for (int q = 0; q < 4; ++q) { const f32x4 x = br[q], y = bi[q];
#pragma unroll
              for (int e = 0; e < 4; ++e) { bbr[4 * q + e] = cr * x[e] - ci * y[e]; bbi[4 * q + e] = cr * y[e] + ci * x[e]; } } }
        { float t0[8], t1[8]; bf8_to_f32(ub0, t0); bf8_to_f32(ub1, t1);
          ubuf[lane * 4 + 0] = (f32x4){t0[0], t0[1], t0[2], t0[3]}; ubuf[lane * 4 + 1] = (f32x4){t0[4], t0[5], t0[6], t0[7]}; ubuf[lane * 4 + 2] = (f32x4){t1[0], t1[1], t1[2], t1[3]}; ubuf[lane * 4 + 3] = (f32x4){t1[4], t1[5], t1[6], t1[7]}; }
        LDS_WAIT(); asm volatile("" ::: "memory");
        f32x2 bb[16];
#pragma unroll
        for (int e = 0; e < 16; ++e) bb[e] = (f32x2){bbr[e], bbi[e]};
        f32x2 sv = {0.f, 0.f}; const f32x2 la = {ar, ar}, lb = {-ai, ai};
        for (int tg = 0; tg < 8; ++tg) { f32x4 ug[8][4];
#pragma unroll
            for (int tt = 0; tt < 8; ++tt)
#pragma unroll
                for (int q = 0; q < 4; ++q) ug[tt][q] = ubuf[(tg * 8 + tt) * 4 + q];
            __builtin_amdgcn_sched_barrier(0);
#pragma unroll
            for (int tt = 0; tt < 8; ++tt) { f32x2 bu0 = {0.f, 0.f}, bu1 = {0.f, 0.f};
#pragma unroll
                for (int q = 0; q < 4; ++q) { const f32x4 u = ug[tt][q];
                    bu0 += bb[4 * q + 0] * (f32x2){u[0], u[0]}; bu1 += bb[4 * q + 1] * (f32x2){u[1], u[1]}; bu0 += bb[4 * q + 2] * (f32x2){u[2], u[2]}; bu1 += bb[4 * q + 3] * (f32x2){u[3], u[3]}; }
                sv = la * sv + lb * (f32x2){sv.y, sv.x} + (bu0 + bu1); } }
        E[(size_t)wu * 64 + lane] = sv;
        LDS_WAIT(); asm volatile("" ::: "memory");
    }
}
__device__ __forceinline__ float gelu_tanh(float y) { return 0.5f * y * (1.0f + tanhf(0.7978845608028654f * (y + 0.044715f * y * y * y))); }
typedef short bf16x8s __attribute__((ext_vector_type(8)));
constexpr int SSM_WLDS = 4096 + 16 * 288;
__device__ __forceinline__ void ssm_final_unit(const Args& a, unsigned char* ws, int l, int wu, LAS unsigned char* wlds, int lane) {
    const bf16_t* proj = (const bf16_t*)(ws + WS_PROJ); const f32x2* E = (const f32x2*)(ws + WS_SSME);
    float* YG = (float*)(ws + WS_YG); bf16_t* YGB = (bf16_t*)(ws + WS_YGB);
    LAS f32x4* ubuf = (LAS f32x4*)wlds; LAS unsigned char* sH = wlds + 4096;
    const int b = wu >> 11, g = (wu >> 6) & 31, ch = wu & 63, fr = lane & 15, q4 = lane >> 4;
    const size_t row0 = (size_t)b * SEQ + ch * 64;
    const bf16_t* up = proj + row0 * NINP + PC_SSM + g * 16;
    const u32x4 ub0 = *(const u32x4*)(up + (size_t)lane * NINP), ub1 = *(const u32x4*)(up + (size_t)lane * NINP + 8);
    float ar, ai, cr, ci; ssm_lambda(a, l, g, lane, ar, ai, cr, ci);
    f32x2 bb[16];
    { const f32x4* br = (const f32x4*)(a.in[I_BRE] + ((size_t)(l * 32 + g) * 64 + lane) * 16); const f32x4* bi = (const f32x4*)(a.in[I_BIM] + ((size_t)(l * 32 + g) * 64 + lane) * 16);
#pragma unroll
      for (int q = 0; q < 4; ++q) { const f32x4 x = br[q], y = bi[q];
#pragma unroll
          for (int e = 0; e < 4; ++e) bb[4 * q + e] = (f32x2){cr * x[e] - ci * y[e], cr * y[e] + ci * x[e]}; } }
    bf16x8s Ah[4], Al[4];
    { const float* cre = a.in[I_CRE] + ((size_t)(l * 32 + g) * 16 + fr) * 64 + 4 * q4; const float* cim = a.in[I_CIM] + ((size_t)(l * 32 + g) * 16 + fr) * 64 + 4 * q4;
#pragma unroll
      for (int ks = 0; ks < 4; ++ks) { const f32x4 xr = *(const f32x4*)(cre + 16 * ks), xi = *(const f32x4*)(cim + 16 * ks);
          const float v[8] = {xr[0], -xi[0], xr[1], -xi[1], xr[2], -xi[2], xr[3], -xi[3]}; u32x4 wh, wl; unsigned hh[4], ll[4];
#pragma unroll
          for (int i = 0; i < 4; ++i) { hh[i] = pk2(v[2 * i], v[2 * i + 1]); ll[i] = pk2(v[2 * i] - bf_lo(hh[i]), v[2 * i + 1] - bf_hi(hh[i])); }
          wh.x = hh[0]; wh.y = hh[1]; wh.z = hh[2]; wh.w = hh[3]; wl.x = ll[0]; wl.y = ll[1]; wl.z = ll[2]; wl.w = ll[3];
          Ah[ks] = __builtin_bit_cast(bf16x8s, wh); Al[ks] = __builtin_bit_cast(bf16x8s, wl); } }
    { float t0[8], t1[8]; bf8_to_f32(ub0, t0); bf8_to_f32(ub1, t1);
      ubuf[lane * 4 + 0] = (f32x4){t0[0], t0[1], t0[2], t0[3]}; ubuf[lane * 4 + 1] = (f32x4){t0[4], t0[5], t0[6], t0[7]}; ubuf[lane * 4 + 2] = (f32x4){t1[0], t1[1], t1[2], t1[3]}; ubuf[lane * 4 + 3] = (f32x4){t1[4], t1[5], t1[6], t1[7]}; }
    float pr = ar, pi = ai;
#pragma unroll
    for (int q = 0; q < 6; ++q) { const float nr = pr * pr - pi * pi, ni = 2.f * pr * pi; pr = nr; pi = ni; }
    float sr = 0.f, si = 0.f;
    { const f32x2* e = E + (size_t)(wu - ch) * 64 + lane;
      for (int m0 = 0; m0 < ch; m0 += 16) { f32x2 ev[16];
#pragma unroll
          for (int i = 0; i < 16; ++i) { const int mm = m0 + i < ch ? m0 + i : ch - 1; ev[i] = e[(size_t)mm * 64]; }
#pragma unroll
          for (int i = 0; i < 16; ++i) if (m0 + i < ch) { const float nr = pr * sr - pi * si + ev[i].x, ni = pr * si + pi * sr + ev[i].y; sr = nr; si = ni; } } }
    const f32x4 dsk = *(const f32x4*)(a.in[I_SD] + l * 512 + g * 16 + 4 * q4);
    f32x2 sv = {sr, si}; const f32x2 la = {ar, ar}, lb = {-ai, ai};
    LDS_WAIT(); asm volatile("" ::: "memory");
    for (int tile = 0; tile < 4; ++tile) {
#pragma unroll
        for (int hg = 0; hg < 2; ++hg) { f32x4 ug[8][4];
#pragma unroll
            for (int tt = 0; tt < 8; ++tt)
#pragma unroll
                for (int q = 0; q < 4; ++q) ug[tt][q] = ubuf[(tile * 16 + hg * 8 + tt) * 4 + q];
            __builtin_amdgcn_sched_barrier(0);
#pragma unroll
            for (int tt = 0; tt < 8; ++tt) { f32x2 bu0 = {0.f, 0.f}, bu1 = {0.f, 0.f};
#pragma unroll
                for (int q = 0; q < 4; ++q) { const f32x4 u = ug[tt][q];
                    bu0 += bb[4 * q + 0] * (f32x2){u[0], u[0]}; bu1 += bb[4 * q + 1] * (f32x2){u[1], u[1]}; bu0 += bb[4 * q + 2] * (f32x2){u[2], u[2]}; bu1 += bb[4 * q + 3] * (f32x2){u[3], u[3]}; }
                sv = la * sv + lb * (f32x2){sv.y, sv.x} + (bu0 + bu1);
                *(LAS unsigned*)(sH + (hg * 8 + tt) * 288 + lane * 4) = pk2(sv.x, sv.y); } }
        LDS_WAIT(); asm volatile("" ::: "memory");
        bf16x8s Bh[4];
#pragma unroll
        for (int ks = 0; ks < 4; ++ks) Bh[ks] = *(const LAS bf16x8s*)(sH + fr * 288 + ks * 64 + q4 * 16);
        const f32x4 u4 = ubuf[(tile * 16 + fr) * 4 + q4];
        f32x4 acc = zero_acc(), acc2 = zero_acc();
#pragma unroll
        for (int ks = 0; ks < 4; ++ks) { acc = __builtin_amdgcn_mfma_f32_16x16x32_bf16(Ah[ks], Bh[ks], acc, 0, 0, 0); acc2 = __builtin_amdgcn_mfma_f32_16x16x32_bf16(Al[ks], Bh[ks], acc2, 0, 0, 0); }
        acc = acc + acc2;
        f32x4 vo;
#pragma unroll
        for (int r = 0; r < 4; ++r) { const float yv = acc[r] + dsk[r] * u4[r];
            const float zz = 0.7978845608028654f * (yv + 0.044715f * yv * yv * yv), th = 1.0f - 2.0f * __builtin_amdgcn_rcpf(__expf(2.0f * zz) + 1.0f); vo[r] = 0.5f * yv * (1.0f + th); }
        const size_t oidx = (row0 + tile * 16 + fr) * 512 + g * 16 + 4 * q4;
        *(f32x4*)(YG + oidx) = vo; u32x2 wb; wb.x = pk2(vo[0], vo[1]); wb.y = pk2(vo[2], vo[3]); *(u32x2*)(YGB + oidx) = wb;
        LDS_WAIT(); asm volatile("" ::: "memory");
    }
}

__device__ __forceinline__ void mix_phase(const Args& a, unsigned char* ws, int l, int blk, int G, int tid) {
    const int lane = tid & 63, wave = __builtin_amdgcn_readfirstlane(tid >> 6), gw = blk * NWAVES + wave, ngw = G * NWAVES;
    const bf16_t* proj = (const bf16_t*)(ws + WS_PROJ); const float* YG = (const float*)(ws + WS_YG); const float* Z = (const float*)(ws + WS_Z);
    const float* DO = (const float*)(ws + WS_DO); const bf16_t* AO = (const bf16_t*)(ws + WS_AO); const float* ALSE = (const float*)(ws + WS_ALSE);
    bf16_t* MIX = (bf16_t*)(ws + WS_MIX);
    const float* glub = a.in[I_GLUB] + l * 512; const float* sg = a.in[I_SGAIN] + l * 512; const float* dng = a.in[I_DNG] + l * 128; const float* atg = a.in[I_ATG] + l * 768;
    for (int m = gw; m < M; m += ngw) {
        const f32x4* yp = (const f32x4*)(YG + (size_t)m * 512 + 8 * lane); const f32x4* zp = (const f32x4*)(Z + (size_t)m * 512 + 8 * lane);
        const f32x4 y0 = yp[0], y1 = yp[1], z0 = zp[0], z1 = zp[1];
        f32x2 od[6]; unsigned zw[6], aw[6][3]; float ls[6][3];
#pragma unroll
        for (int h = 0; h < 6; ++h) { od[h] = *(const f32x2*)(DO + (size_t)m * 768 + h * 128 + 2 * lane); zw[h] = *(const unsigned*)(proj + (size_t)m * NINP + PC_DZ + h * 128 + 2 * lane);
#pragma unroll
            for (int g3 = 0; g3 < 3; ++g3) { ls[h][g3] = ALSE[((size_t)g3 * M + m) * 8 + h]; aw[h][g3] = *(const unsigned*)(AO + ((size_t)g3 * M + m) * 768 + h * 128 + 2 * lane); } }
        const f32x4* bp = (const f32x4*)(glub + 8 * lane); const f32x4 b0 = bp[0], b1 = bp[1];
        float red[8];
        float v[8];
#pragma unroll
        for (int e = 0; e < 4; ++e) { v[e] = y0[e] * sigmoidf_(z0[e] + b0[e]); v[4 + e] = y1[e] * sigmoidf_(z1[e] + b1[e]); }
        red[0] = 0.f;
#pragma unroll
        for (int e = 0; e < 8; ++e) red[0] += v[e] * v[e];
#pragma unroll
        for (int h = 0; h < 6; ++h) red[1 + h] = od[h].x * od[h].x + od[h].y * od[h].y;
        float oa[6][2]; red[7] = 0.f;
#pragma unroll
        for (int h = 0; h < 6; ++h) { const float mx = fmaxf(ls[h][0], fmaxf(ls[h][1], ls[h][2])); const float w0 = __expf(ls[h][0] - mx), w1 = __expf(ls[h][1] - mx), w2 = __expf(ls[h][2] - mx), inv = 1.f / (w0 + w1 + w2);
            oa[h][0] = (w0 * bf_lo(aw[h][0]) + w1 * bf_lo(aw[h][1]) + w2 * bf_lo(aw[h][2])) * inv; oa[h][1] = (w0 * bf_hi(aw[h][0]) + w1 * bf_hi(aw[h][1]) + w2 * bf_hi(aw[h][2])) * inv;
            red[7] += oa[h][0] * oa[h][0] + oa[h][1] * oa[h][1]; }
#pragma unroll
        for (int o = 1; o < 64; o <<= 1) {
#pragma unroll
            for (int i = 0; i < 8; ++i) red[i] += shx(lane, red[i], o); }
        { const float r = rsqrtf(red[0] * (1.f / 512.f) + EPS); const f32x4* gp = (const f32x4*)(sg + 8 * lane); const f32x4 g0 = gp[0], g1 = gp[1];
          u32x4 w; w.x = pk2(v[0] * r * g0.x, v[1] * r * g0.y); w.y = pk2(v[2] * r * g0.z, v[3] * r * g0.w); w.z = pk2(v[4] * r * g1.x, v[5] * r * g1.y); w.w = pk2(v[6] * r * g1.z, v[7] * r * g1.w);
          *(u32x4*)(MIX + (size_t)m * D + 8 * lane) = w; }
        { const f32x2 g = *(const f32x2*)(dng + 2 * lane);
#pragma unroll
          for (int h = 0; h < 6; ++h) { const float r = rsqrtf(red[1 + h] * (1.f / 128.f) + EPS);
              *(unsigned*)(MIX + (size_t)m * D + 512 + h * 128 + 2 * lane) = pk2(od[h].x * r * g.x * siluf_(bf_lo(zw[h])), od[h].y * r * g.y * siluf_(bf_hi(zw[h]))); } }
        { const float r = rsqrtf(red[7] * (1.f / 768.f) + EPS);
#pragma unroll
          for (int h = 0; h < 6; ++h) { const f32x2 g = *(const f32x2*)(atg + h * 128 + 2 * lane);
              *(unsigned*)(MIX + (size_t)m * D + 1280 + h * 128 + 2 * lane) = pk2(oa[h][0] * r * g.x, oa[h][1] * r * g.y); } }
    }
}

typedef pg8::StaticOrder GemmOrder;
typedef short bf16x8 __attribute__((ext_vector_type(8)));
__device__ __forceinline__ int kperm(int k) { return (k & ~31) + 8 * ((k & 15) >> 2) + 4 * ((k >> 4) & 1) + (k & 3); }
__device__ __forceinline__ bf16x8 pack8(const f32x4 a, const f32x4 b) { u32x4 w; w.x = pk2(a[0], a[1]); w.y = pk2(a[2], a[3]); w.z = pk2(b[0], b[1]); w.w = pk2(b[2], b[3]); return __builtin_bit_cast(bf16x8, w); }
constexpr int DP_KS = 0, DP_VS = 33024, DP_QS = 66048, DP_KB = 99072, DP_QB = 117504, DP_MISC = 135936, DP_ATL = 137216, DP_AP = 68;
template <int C, int E0> __device__ __forceinline__ void dn_solve_batch(const LAS float* Amv, const float (&x)[64], float& s0, float& s1, float& s2, float& s3) {
    constexpr int NP = (C + 3) / 4, NB = (NP - E0) < 8 ? (NP - E0) : 8;
    if constexpr (NB > 0) { f32x4 av[NB];
#pragma unroll
        for (int i = 0; i < NB; ++i) av[i] = *(const LAS f32x4*)(Amv + C * DP_AP + 4 * (E0 + i));
        __builtin_amdgcn_sched_barrier(0);
#pragma unroll
        for (int i = 0; i < NB; ++i) { constexpr int dummy = 0; (void)dummy; const int e4 = E0 + i;
            if (4 * e4 + 0 < C) s0 -= av[i][0] * x[4 * e4 + 0]; if (4 * e4 + 1 < C) s1 -= av[i][1] * x[4 * e4 + 1];
            if (4 * e4 + 2 < C) s2 -= av[i][2] * x[4 * e4 + 2]; if (4 * e4 + 3 < C) s3 -= av[i][3] * x[4 * e4 + 3]; }
        __builtin_amdgcn_sched_barrier(0); }
}
template <int C> __device__ __forceinline__ void dn_solve_rows(const LAS float* Amv, float (&x)[64]) {
    if constexpr (C < 64) { float s0 = x[C], s1 = 0.f, s2 = 0.f, s3 = 0.f;
        dn_solve_batch<C, 0>(Amv, x, s0, s1, s2, s3); dn_solve_batch<C, 8>(Amv, x, s0, s1, s2, s3);
        x[C] = (s0 + s1) + (s2 + s3);
        dn_solve_rows<C + 1>(Amv, x); }
}
__device__ __forceinline__ void dn_chunk_prep(const Args& a, unsigned char* ws, int l, int unit, LAS unsigned char* lds, int tid_in) {
    int tid = tid_in; asm volatile("" : "+v"(tid));
    const int lane = tid & 63, wave = __builtin_amdgcn_readfirstlane(tid >> 6), q4 = lane >> 4, fr = lane & 15;
    const bf16_t* proj = (const bf16_t*)(ws + WS_PROJ);
    const int bh = unit >> 6, n = unit & 63, b = bh / 6, h = bh % 6, t0 = n * 64; const size_t row0 = (size_t)b * SEQ + t0;
    LAS float* ks = (LAS float*)(lds + DP_KS); LAS float* vs = (LAS float*)(lds + DP_VS); LAS float* qs = (LAS float*)(lds + DP_QS);
    LAS unsigned char* kb = lds + DP_KB; LAS unsigned char* qb = lds + DP_QB; LAS float* gcs = (LAS float*)(lds + DP_MISC); LAS float* bes = gcs + 64; LAS float* egs = gcs + 128; LAS float* eks = gcs + 192;
    bf16_t* WN = (bf16_t*)(ws + WS_DWN) + (size_t)unit * 8192; bf16_t* QD = (bf16_t*)(ws + WS_DQD) + (size_t)unit * 8192; bf16_t* KT = (bf16_t*)(ws + WS_DKT) + (size_t)unit * 8192;
    bf16_t* AT = (bf16_t*)(ws + WS_DAT) + (size_t)unit * 4096; float* UD = (float*)(ws + WS_DUD) + (size_t)unit * 8192; float* CD = (float*)(ws + WS_DCD);
    const float* cw = a.in[I_CONVW] + (size_t)l * 4 * 2304;
    __syncthreads();
    { const int d2 = tid & 63, c0 = 8 * (tid >> 6); unsigned xin[3][11]; float wv[3][4][2];
#pragma unroll
      for (int w3 = 0; w3 < 3; ++w3) { const int chn = w3 * 768 + h * 128 + 2 * d2;
#pragma unroll
          for (int i = 0; i < 4; ++i) { const f32x2 w2 = *(const f32x2*)(cw + i * 2304 + chn); wv[w3][i][0] = w2.x; wv[w3][i][1] = w2.y; }
#pragma unroll
          for (int i = 0; i < 11; ++i) xin[w3][i] = (t0 + c0 - 3 + i >= 0) ? *(const unsigned*)(proj + (row0 + c0 - 3 + i) * NINP + PC_DQKV + chn) : 0u; }
#pragma unroll
      for (int w3 = 0; w3 < 3; ++w3) { LAS float* dst = w3 == 0 ? qs : (w3 == 1 ? ks : vs);
#pragma unroll
          for (int c = 0; c < 8; ++c) {
              const float a0 = wv[w3][0][0] * bf_lo(xin[w3][c]) + wv[w3][1][0] * bf_lo(xin[w3][c + 1]) + wv[w3][2][0] * bf_lo(xin[w3][c + 2]) + wv[w3][3][0] * bf_lo(xin[w3][c + 3]);
              const float a1 = wv[w3][0][1] * bf_hi(xin[w3][c]) + wv[w3][1][1] * bf_hi(xin[w3][c + 1]) + wv[w3][2][1] * bf_hi(xin[w3][c + 2]) + wv[w3][3][1] * bf_hi(xin[w3][c + 3]);
              dst[(c0 + c) * 129 + 2 * d2] = a0 * __builtin_amdgcn_rcpf(1.0f + __builtin_amdgcn_exp2f(-1.44269504089f * a0));
              dst[(c0 + c) * 129 + 2 * d2 + 1] = a1 * __builtin_amdgcn_rcpf(1.0f + __builtin_amdgcn_exp2f(-1.44269504089f * a1)); } } }
    if (wave == 0) { const size_t row = row0 + lane; const float av = __uint_as_float((unsigned)proj[row * NINP + PC_DA + h] << 16), bv = __uint_as_float((unsigned)proj[row * NINP + PC_DB + h] << 16);
        const float x = av + a.in[I_DTB][l * 6 + h]; const float sp = fmaxf(x, 0.f) + log1pf(expf(-fabsf(x))); float g = -expf(a.in[I_ALOG][l * 6 + h]) * sp;
#pragma unroll
        for (int o = 1; o < 64; o <<= 1) { const float t = __int_as_float(__builtin_amdgcn_ds_bpermute(((lane - o) & 63) << 2, __float_as_int(g))); if (lane >= o) g += t; }
        const float glast = __int_as_float(__builtin_amdgcn_readlane(__float_as_int(g), 63));
        gcs[lane] = g; bes[lane] = sigmoidf_(bv); egs[lane] = expf(g); eks[lane] = expf(glast - g); if (lane == 63) CD[unit] = expf(g); }
    __syncthreads();
    { const int c = wave * 8 + (lane >> 3), sg = lane & 7; float qv[16], kv[16]; float sq = 0.f, sk = 0.f;
#pragma unroll
      for (int i = 0; i < 16; ++i) { qv[i] = qs[c * 129 + 16 * sg + i]; kv[i] = ks[c * 129 + 16 * sg + i]; sq += qv[i] * qv[i]; sk += kv[i] * kv[i]; }
#pragma unroll
      for (int o = 1; o < 8; o <<= 1) { sq += shx(lane, sq, o); sk += shx(lane, sk, o); }
      const float qsc = rsqrtf(sq + EPS) * 0.08838834764831845f, ksc = rsqrtf(sk + EPS);
#pragma unroll
      for (int i = 0; i < 16; ++i) { qv[i] *= qsc; kv[i] *= ksc; qs[c * 129 + 16 * sg + i] = qv[i]; ks[c * 129 + 16 * sg + i] = kv[i]; }
      u32x4 w0, w1; w0.x = pk2(qv[0], qv[1]); w0.y = pk2(qv[2], qv[3]); w0.z = pk2(qv[4], qv[5]); w0.w = pk2(qv[6], qv[7]); w1.x = pk2(qv[8], qv[9]); w1.y = pk2(qv[10], qv[11]); w1.z = pk2(qv[12], qv[13]); w1.w = pk2(qv[14], qv[15]);
      *(LAS u32x4*)(qb + c * 288 + sg * 32) = w0; *(LAS u32x4*)(qb + c * 288 + sg * 32 + 16) = w1;
      w0.x = pk2(kv[0], kv[1]); w0.y = pk2(kv[2], kv[3]); w0.z = pk2(kv[4], kv[5]); w0.w = pk2(kv[6], kv[7]); w1.x = pk2(kv[8], kv[9]); w1.y = pk2(kv[10], kv[11]); w1.z = pk2(kv[12], kv[13]); w1.w = pk2(kv[14], kv[15]);
      *(LAS u32x4*)(kb + c * 288 + sg * 32) = w0; *(LAS u32x4*)(kb + c * 288 + sg * 32 + 16) = w1; }
    __syncthreads();
#pragma unroll
    for (int i = 0; i < 2; ++i) { const int pi = tid + NTHR * i, c = pi >> 4, pc = pi & 15, s0 = (pc >> 2) * 32 + 4 * (pc & 3); float v[8];
#pragma unroll
        for (int j = 0; j < 4; ++j) { v[j] = qs[c * 129 + s0 + j]; v[4 + j] = qs[c * 129 + s0 + 16 + j]; }
        const float sc = egs[c]; u32x4 w; w.x = pk2(v[0] * sc, v[1] * sc); w.y = pk2(v[2] * sc, v[3] * sc); w.z = pk2(v[4] * sc, v[5] * sc); w.w = pk2(v[6] * sc, v[7] * sc);
        *(u32x4*)(QD + c * 128 + pc * 8) = w; }
#pragma unroll
    for (int i = 0; i < 2; ++i) { const int pi = tid + NTHR * i, dk = pi >> 3, pc = pi & 7, c0 = (pc >> 2) * 32 + 4 * (pc & 3); float v[8], e[8];
#pragma unroll
        for (int j = 0; j < 4; ++j) { v[j] = ks[(c0 + j) * 129 + dk]; v[4 + j] = ks[(c0 + 16 + j) * 129 + dk]; e[j] = eks[c0 + j]; e[4 + j] = eks[c0 + 16 + j]; }
        u32x4 w; w.x = pk2(v[0] * e[0], v[1] * e[1]); w.y = pk2(v[2] * e[2], v[3] * e[3]); w.z = pk2(v[4] * e[4], v[5] * e[5]); w.w = pk2(v[6] * e[6], v[7] * e[7]);
        *(u32x4*)(KT + dk * 64 + pc * 8) = w; }
    __syncthreads();
    LAS float* Am = qs;
    for (int job = wave; job < 32; job += NWAVES) { const int kind = job >> 4, ti = (job >> 2) & 3, tj = job & 3;
        f32x4 acc = zero_acc();
        if (ti >= tj) { const LAS unsigned char* ab = (kind ? qb : kb) + (16 * ti + fr) * 288 + q4 * 16; const LAS unsigned char* bb = kb + (16 * tj + fr) * 288 + q4 * 16;
#pragma unroll
            for (int k4 = 0; k4 < 4; ++k4) acc = __builtin_amdgcn_mfma_f32_16x16x32_bf16(*(const LAS bf16x8*)(ab + k4 * 64), *(const LAS bf16x8*)(bb + k4 * 64), acc, 0, 0, 0); }
        const int e = 16 * tj + fr; const float ge = gcs[e];
#pragma unroll
        for (int r = 0; r < 4; ++r) { const int c = 16 * ti + 4 * q4 + r; const float dec = expf(fminf(gcs[c] - ge, 0.f));
            if (kind == 0) { Am[c * DP_AP + e] = (c > e) ? bes[c] * acc[r] * dec : 0.f; }
            else { *(LAS bf16_t*)(lds + DP_ATL + c * 144 + kperm(e) * 2) = (bf16_t)(pk2((c >= e) ? acc[r] * dec : 0.f, 0.f) & 0xffffu); } } }
    __syncthreads();
    { const int c = tid >> 3, pc = tid & 7; *(u32x4*)(AT + c * 64 + pc * 8) = *(const LAS u32x4*)(lds + DP_ATL + c * 144 + pc * 16); }
    if (tid < 256) { const int col = tid & 127; const bool isw = tid >= 128; float x[64]; int zoff = 0; asm volatile("" : "+v"(zoff));
        const LAS float* Amv = Am + zoff;
        { const LAS float* src = (isw ? ks : vs) + col; const LAS f32x4* b4p = (const LAS f32x4*)(bes + zoff); const LAS f32x4* e4p = (const LAS f32x4*)(egs + zoff);
#pragma unroll
          for (int c = 0; c < 64; ++c) x[c] = src[c * 129];
#pragma unroll
          for (int g4 = 0; g4 < 4; ++g4) { f32x4 b4[4], e4[4];
#pragma unroll
              for (int i = 0; i < 4; ++i) { b4[i] = b4p[4 * g4 + i]; e4[i] = e4p[4 * g4 + i]; }
#pragma unroll
              for (int c = 0; c < 16; ++c) x[16 * g4 + c] = x[16 * g4 + c] * b4[c >> 2][c & 3] * (isw ? e4[c >> 2][c & 3] : 1.0f); } }
        dn_solve_rows<1>(Amv, x);
        if (!isw) { const int s8 = col >> 4, f = col & 15;
#pragma unroll
            for (int mt = 0; mt < 4; ++mt)
#pragma unroll
                for (int qq = 0; qq < 4; ++qq) *(f32x4*)(UD + ((size_t)((s8 * 4 + mt) * 64 + qq * 16 + f)) * 4) = (f32x4){x[16 * mt + 4 * qq], x[16 * mt + 4 * qq + 1], x[16 * mt + 4 * qq + 2], x[16 * mt + 4 * qq + 3]}; }
        else { const int p = kperm(col);
#pragma unroll
            for (int c = 0; c < 64; ++c) *(LAS bf16_t*)(kb + c * 288 + p * 2) = (bf16_t)(pk2(-x[c], 0.f) & 0xffffu); } }
    __syncthreads();
#pragma unroll
    for (int i = 0; i < 2; ++i) { const int pi = tid + NTHR * i, c = pi >> 4, pc = pi & 15; *(u32x4*)(WN + c * 128 + pc * 8) = *(const LAS u32x4*)(kb + c * 288 + pc * 16); }
}
constexpr int DS2_WN = 0, DS2_KT = 18432, DS2_BYTES = 38912;
__device__ __forceinline__ void dn_scan_wg2(unsigned char* ws, int bh, int half, LAS unsigned char* lds, int tid) {
    const int lane = tid & 63, wv = __builtin_amdgcn_readfirstlane(tid >> 6), s8 = half * 4 + (wv & 3), q4 = lane >> 4, fr = lane & 15; const bool cw = wv < 4;
    const f32x4 z4 = {0.f, 0.f, 0.f, 0.f};
    f32x4 S[8]; bf16x8 Sb[4];
#pragma unroll
    for (int i = 0; i < 8; ++i) S[i] = z4;
#pragma unroll
    for (int i = 0; i < 4; ++i) Sb[i] = pack8(z4, z4);
    const int r16a = tid >> 4, pc16 = tid & 15, r8a = tid >> 3, pc8 = tid & 7;
    const unsigned char* gWN = ws + WS_DWN + (size_t)bh * 64 * 16384; const unsigned char* gKT = ws + WS_DKT + (size_t)bh * 64 * 16384;
    const f32x4* gUD = (const f32x4*)(ws + WS_DUD) + ((size_t)bh * 64 * 8 + s8) * 256 + lane;
    bf16x8* gSS = (bf16x8*)(ws + WS_DSS) + ((size_t)bh * 64 * 8 + s8) * 256 + lane; bf16x8* gVN = (bf16x8*)(ws + WS_DVN) + ((size_t)bh * 64 * 8 + s8) * 128 + lane;
    u32x4 st[4]; f32x4 udn[4]; float decn;
    const float* gCD = (const float*)(ws + WS_DCD) + bh * 64;
#define DN_LOAD2(n_) do { const size_t o16 = (size_t)(n_) * 16384; \
        st[0] = *(const u32x4*)(gWN + o16 + r16a * 256 + pc16 * 16); st[1] = *(const u32x4*)(gWN + o16 + (r16a + 32) * 256 + pc16 * 16); \
        st[2] = *(const u32x4*)(gKT + o16 + r8a * 128 + pc8 * 16); st[3] = *(const u32x4*)(gKT + o16 + (r8a + 64) * 128 + pc8 * 16); \
        decn = gCD[n_]; \
        if (cw) { _Pragma("unroll") for (int mt = 0; mt < 4; ++mt) udn[mt] = gUD[(size_t)(n_) * 2048 + mt * 64]; } } while (0)
    DN_LOAD2(0);
    const LAS unsigned char* aW = lds + DS2_WN + fr * 288 + q4 * 16; const LAS unsigned char* aK = lds + DS2_KT + fr * 160 + q4 * 16;
    for (int n = 0; n < 64; ++n) {
        __syncthreads();
        *(LAS u32x4*)(lds + DS2_WN + r16a * 288 + pc16 * 16) = st[0]; *(LAS u32x4*)(lds + DS2_WN + (r16a + 32) * 288 + pc16 * 16) = st[1];
        *(LAS u32x4*)(lds + DS2_KT + r8a * 160 + pc8 * 16) = st[2]; *(LAS u32x4*)(lds + DS2_KT + (r8a + 64) * 160 + pc8 * 16) = st[3];
        f32x4 vn[4];
#pragma unroll
        for (int mt = 0; mt < 4; ++mt) vn[mt] = udn[mt];
        const float dec = decn;
        if (cw) {
#pragma unroll
        for (int i = 0; i < 4; ++i) gSS[(size_t)n * 2048 + i * 64] = Sb[i]; }
        { const int nn = n + 1 < 64 ? n + 1 : 63; DN_LOAD2(nn); }
        __syncthreads();
        if (cw) {
        bf16x8 fw[16], fk[16];
#pragma unroll
        for (int i = 0; i < 16; ++i) fw[i] = *(const LAS bf16x8*)(aW + (i >> 2) * 16 * 288 + (i & 3) * 64);
        __builtin_amdgcn_sched_barrier(0);
#pragma unroll
        for (int k4 = 0; k4 < 4; ++k4)
#pragma unroll
            for (int mt = 0; mt < 4; ++mt) vn[mt] = __builtin_amdgcn_mfma_f32_16x16x32_bf16(fw[mt * 4 + k4], Sb[k4], vn[mt], 0, 0, 0);
        __builtin_amdgcn_sched_barrier(0);
#pragma unroll
        for (int i = 0; i < 16; ++i) fk[i] = *(const LAS bf16x8*)(aK + (i >> 1) * 16 * 160 + (i & 1) * 64);
#pragma unroll
        for (int t8 = 0; t8 < 8; ++t8) S[t8] = S[t8] * dec;
        bf16x8 Vb[2]; Vb[0] = pack8(vn[0], vn[1]); Vb[1] = pack8(vn[2], vn[3]);
        gVN[(size_t)n * 1024] = Vb[0]; gVN[(size_t)n * 1024 + 64] = Vb[1];
        __builtin_amdgcn_sched_barrier(0);
#pragma unroll
        for (int k2 = 0; k2 < 2; ++k2)
#pragma unroll
            for (int t8 = 0; t8 < 8; ++t8) S[t8] = __builtin_amdgcn_mfma_f32_16x16x32_bf16(fk[t8 * 2 + k2], Vb[k2], S[t8], 0, 0, 0);
#pragma unroll
        for (int i = 0; i < 4; ++i) Sb[i] = pack8(S[2 * i], S[2 * i + 1]);
        }
    }
#undef DN_LOAD2
    __syncthreads();
}
__device__ __forceinline__ void dn_out_unit(unsigned char* ws, int unit, int tid) {
    const int lane = tid & 63, s8 = __builtin_amdgcn_readfirstlane(tid >> 6), q4 = lane >> 4, fr = lane & 15;
    const int bh = unit >> 6, n = unit & 63, b = bh / 6, h = bh % 6;
    const bf16_t* qd = (const bf16_t*)(ws + WS_DQD) + (size_t)unit * 8192 + fr * 128 + q4 * 8; const bf16_t* at = (const bf16_t*)(ws + WS_DAT) + (size_t)unit * 4096 + fr * 64 + q4 * 8;
    const bf16x8* gSS = (const bf16x8*)(ws + WS_DSS) + ((size_t)unit * 8 + s8) * 256 + lane; const bf16x8* gVN = (const bf16x8*)(ws + WS_DVN) + ((size_t)unit * 8 + s8) * 128 + lane;
    bf16x8 Sb[4], Vb[2], fq[16], fa[8];
#pragma unroll
    for (int i = 0; i < 4; ++i) Sb[i] = gSS[i * 64];
    Vb[0] = gVN[0]; Vb[1] = gVN[64];
#pragma unroll
    for (int i = 0; i < 16; ++i) fq[i] = *(const bf16x8*)(qd + (i >> 2) * 2048 + (i & 3) * 32);
#pragma unroll
    for (int i = 0; i < 8; ++i) fa[i] = *(const bf16x8*)(at + (i >> 1) * 1024 + (i & 1) * 32);
    __builtin_amdgcn_sched_barrier(0);
    f32x4 o[4]; float* DO = (float*)(ws + WS_DO);
#pragma unroll
    for (int mt = 0; mt < 4; ++mt) o[mt] = zero_acc();
#pragma unroll
    for (int k4 = 0; k4 < 4; ++k4)
#pragma unroll
        for (int mt = 0; mt < 4; ++mt) o[mt] = __builtin_amdgcn_mfma_f32_16x16x32_bf16(fq[mt * 4 + k4], Sb[k4], o[mt], 0, 0, 0);
#pragma unroll
    for (int k2 = 0; k2 < 2; ++k2)
#pragma unroll
        for (int mt = 0; mt < 4; ++mt) o[mt] = __builtin_amdgcn_mfma_f32_16x16x32_bf16(fa[mt * 2 + k2], Vb[k2], o[mt], 0, 0, 0);
#pragma unroll
    for (int mt = 0; mt < 4; ++mt) { float* orow = DO + ((size_t)b * SEQ + n * 64 + 16 * mt + 4 * q4) * 768 + h * 128 + 16 * s8 + fr;
#pragma unroll
        for (int r = 0; r < 4; ++r) orow[(size_t)r * 768] = o[mt][r]; }
}

typedef short s16x4 __attribute__((ext_vector_type(4)));
constexpr int A2_K = 0, A2_V = 73728, A2_BIAS = 147456, A2_P = 288;
__device__ __forceinline__ s16x4 tr_read(const LAS unsigned char* p) { return __builtin_bit_cast(s16x4, __builtin_amdgcn_ds_read_tr16_b64_v4i16((LAS s16x4*)p)); }
__device__ __forceinline__ void attn_unit_mfma(const Args& a, unsigned char* ws, int unit, LAS unsigned char* lds, int tid) {
    const int lane = tid & 63, w = __builtin_amdgcn_readfirstlane(tid >> 6), q4 = lane >> 4, fr = lane & 15;
    const bf16_t* proj = (const bf16_t*)(ws + WS_PROJ);
    const int gi = unit / 384, rem = unit % 384, b = rem / 192, h = (rem >> 5) % 6, idx = rem & 31;
    const int dl = gi == 0 ? 1 : (gi == 1 ? 4 : 16), r = idx % dl, qb = idx / dl, i0 = qb * 128;
    bf16_t* AO = (bf16_t*)(ws + WS_AO) + (size_t)gi * M * 768; float* ALSE = (float*)(ws + WS_ALSE) + (size_t)gi * M * 8;
    LAS unsigned char* Kl = lds + A2_K; LAS unsigned char* Vl = lds + A2_V; LAS float* biasT = (LAS float*)(lds + A2_BIAS);
    __syncthreads();
    { u32x4 kw[8], vw[8];
#pragma unroll
      for (int i = 0; i < 8; ++i) { const int it = tid + NTHR * i, kk = it >> 4, c8 = it & 15, j = i0 - 128 + kk; const int jj = j < 0 ? 0 : j;
          const size_t row = (size_t)b * SEQ + (size_t)jj * dl + r; kw[i] = *(const u32x4*)(proj + row * NINP + PC_AK + h * 128 + 8 * c8); vw[i] = *(const u32x4*)(proj + row * NINP + PC_AV + h * 128 + 8 * c8); }
#pragma unroll
      for (int i = 0; i < 8; ++i) { const int it = tid + NTHR * i, kk = it >> 4, c8 = it & 15;
          *(LAS u32x4*)(Kl + kk * A2_P + c8 * 16) = kw[i]; *(LAS u32x4*)(Vl + kk * A2_P + c8 * 16) = vw[i]; } }
    if (tid < 129) { const int dist = tid * dl; int bucket;
        if (dist < 16) bucket = dist; else { const float lg = 16.f + logf((float)dist / 16.f) / 4.852030263919617f * 16.f; bucket = (int)lg; bucket = bucket > 31 ? 31 : bucket; }
        biasT[tid] = a.in[I_RELB][bucket * 6 + h]; }
    const size_t qrow = (size_t)b * SEQ + (size_t)(i0 + 16 * w + fr) * dl + r;
    bf16x8 Qf[4];
    { const bf16_t* qp = proj + qrow * NINP + PC_AQ + h * 128 + 8 * q4;
#pragma unroll
      for (int ks = 0; ks < 4; ++ks) Qf[ks] = *(const bf16x8*)(qp + 32 * ks); }
    __syncthreads();
    f32x4 sc9[9]; float mx = -1e30f;
#pragma unroll
    for (int t = 0; t < 9; ++t) { f32x4 acc = zero_acc(); const LAS unsigned char* kr = Kl + (16 * (w + t) + fr) * A2_P + q4 * 16;
#pragma unroll
        for (int ks = 0; ks < 4; ++ks) acc = __builtin_amdgcn_mfma_f32_16x16x32_bf16(*(const LAS bf16x8*)(kr + ks * 64), Qf[ks], acc, 0, 0, 0);
#pragma unroll
        for (int e = 0; e < 4; ++e) { const int rel = 128 + fr - 16 * t - 4 * q4 - e, kl = 16 * (w + t) + 4 * q4 + e; const bool valid = (rel >= 0) && (rel <= 128) && (i0 - 128 + kl >= 0);
            const float s = valid ? acc[e] * 0.08838834764831845f + biasT[rel < 0 ? 0 : (rel > 128 ? 128 : rel)] : -1e30f; acc[e] = s; mx = fmaxf(mx, s); }
        sc9[t] = acc; }
    mx = fmaxf(mx, shx(lane, mx, 16)); mx = fmaxf(mx, shx(lane, mx, 32));
    float sum = 0.f;
#pragma unroll
    for (int t = 0; t < 9; ++t)
#pragma unroll
        for (int e = 0; e < 4; ++e) { const float p = __expf(sc9[t][e] - mx); sc9[t][e] = p; sum += p; }
    sum += shx(lane, sum, 16); sum += shx(lane, sum, 32);
    f32x4 o[8];
#pragma unroll
    for (int dt = 0; dt < 8; ++dt) o[dt] = zero_acc();
    const f32x4 z4 = {0.f, 0.f, 0.f, 0.f};
#pragma unroll
    for (int s = 0; s < 5; ++s) { const bf16x8 Pf = pack8(sc9[2 * s], s < 4 ? sc9[2 * s + 1] : z4);
        const LAS unsigned char* v0 = Vl + (16 * w + 32 * s + 4 * q4 + (fr >> 2)) * A2_P + 8 * (fr & 3); const LAS unsigned char* v1 = s < 4 ? v0 + 16 * A2_P : v0;
#pragma unroll
        for (int dt = 0; dt < 8; ++dt) { const s16x4 lo = tr_read(v0 + dt * 32), hi = tr_read(v1 + dt * 32);
            const bf16x8 Vf = {lo[0], lo[1], lo[2], lo[3], hi[0], hi[1], hi[2], hi[3]};
            o[dt] = __builtin_amdgcn_mfma_f32_16x16x32_bf16(Vf, Pf, o[dt], 0, 0, 0); } }
    const float inv = 1.f / sum;
    bf16_t* orow = AO + qrow * 768 + h * 128 + 4 * q4;
#pragma unroll
    for (int dt = 0; dt < 8; ++dt) { u32x2 w; w.x = pk2(o[dt][0] * inv, o[dt][1] * inv); w.y = pk2(o[dt][2] * inv, o[dt][3] * inv); *(u32x2*)(orow + 16 * dt) = w; }
    if (q4 == 0) ALSE[qrow * 8 + h] = mx + logf(sum);
}

constexpr int PH_PER_LAYER = 13, NPH = 1 + PH_PER_LAYER * DEPTH;
__global__ void __launch_bounds__(NTHR, 2) fwd_kernel(Args args) {
    extern __shared__ __attribute__((aligned(16))) unsigned char lds_raw[];
    LAS unsigned char* lds = (LAS unsigned char*)lds_raw;
    volatile LAS unsigned* MISC = (volatile LAS unsigned*)(lds + MISC_OFF);
    const int tid = threadIdx.x;
    const int G = gridDim.x, blk = blockIdx.x;
    const int lo = args.ph_lo, hi = args.ph_hi;
    unsigned char* ws = args.ws;
    if (tid < 64) MISC[tid] = 0u;
    __syncthreads();
    XcdBarrier bar; bar.bar = (unsigned*)(ws + WS_CTL) + CW_BAR; bar.x = 0; bar.st = nullptr;
    if (hi - lo > 1) bar = xcd_barrier_post((unsigned*)(ws + WS_CTL) + CW_BAR, MISC + 8);
#define IN(k) (lo <= (k) && (k) < hi)
#define FRESH() int tidl = tid; unsigned wz_ = 0; asm volatile("" : "+v"(tidl), "+s"(wz_)); unsigned char* wsl = ws + wz_
#define SEAM(k) do { if (IN(k) && IN((k) + 1)) xcd_barrier(bar); } while (0)

    if (IN(0)) { FRESH(); p0_prologue(args, wsl, lds, blk, G, tidl); }
    SEAM(0);
    for (int l = 0; l < DEPTH; ++l) {
        const int pb = 1 + PH_PER_LAYER * l;
        const float* gains = args.in[I_GAINS] + (size_t)l * 6 * D;
#pragma unroll
        for (int f = 0; f < 2; ++f) {
            const int p0 = pb + (f ? 10 : 0);
            if (IN(p0)) {
                FRESH(); pg8::Gemm g{(const bf16_t*)(wsl + WS_H), (const bf16_t*)(wsl + WS_WGU) + (size_t)(l * 2 + f) * NGU * D, M, NGU, D};
                pg8::EpiSwiGLU E{(bf16_t*)(wsl + WS_ACT), DFF};
                GemmOrder S; S.init(M, NGU, G, blk); pg8::gemm_phase<pg8::EpiSwiGLU, GemmOrder, true, true>(lds, g, S, E, tidl);
                conv_slot(args, wsl, l + 1, l * 3 + f, (unsigned)G, lds, MISC, tidl);
            }
            SEAM(p0);
            if (IN(p0 + 1)) {
                FRESH(); pg8::Gemm g{(const bf16_t*)(wsl + WS_ACT), (const bf16_t*)(wsl + WS_WD) + (size_t)(l * 2 + f) * D * DFF, M, D, DFF}; GemmOrder S; S.init(M, D, G, blk);
                pg8::EpiBf16P E{(bf16_t*)(wsl + WS_Y), D};
                pg8::gemm_phase<pg8::EpiBf16P, GemmOrder, true, true>(lds, g, S, E, tidl);
            }
            SEAM(p0 + 1);
            if (IN(p0 + 2)) {
                const bool last = (f == 1 && l == DEPTH - 1);
                if (f == 1) { FRESH(); conv_slot(args, wsl, l + 1, 15, 0u, lds, MISC, tidl); }
                FRESH(); bf16_t* X = (bf16_t*)(wsl + WS_X); const bf16_t* Yb = (const bf16_t*)(wsl + WS_Y); bf16_t* Hb = (bf16_t*)(wsl + WS_H);
                const float* gpre = f == 0 ? gains + 2 * D : (last ? gains : args.in[I_GAINS] + (size_t)(l + 1) * 6 * D); const float* gpost = gains + (f ? 5 : 1) * D;
                if (f == 0 && l == 0) thin_phase<true, false>(args.in[I_X], X, Yb, gpost, 0.5f, gpre, Hb, blk, G, tidl);
                else if (last) thin_phase<false, true>(X, args.out, Yb, gpost, 0.5f, gpre, (bf16_t*)nullptr, blk, G, tidl);
                else thin_phase<false, false>(X, X, Yb, gpost, 0.5f, gpre, Hb, blk, G, tidl);
            }
            SEAM(p0 + 2);
            if (f == 1) break;
            if (IN(pb + 3)) {
                FRESH(); pg8::Gemm g{(const bf16_t*)(wsl + WS_H), (const bf16_t*)(wsl + WS_WIN) + (size_t)l * NINP * D, M, NINP, D}; GemmOrder S; S.init(M, NINP, G, blk);
                pg8::EpiBf16P E{(bf16_t*)(wsl + WS_PROJ), NINP};
                pg8::gemm_phase<pg8::EpiBf16P, GemmOrder, true, true>(lds, g, S, E, tidl);
            }
            SEAM(pb + 3);
            if (IN(pb + 4)) { FRESH();
                ssm_local(args, wsl, l, blk, G, tidl, lds);
                for (int u = blk; u < 768; u += G) dn_chunk_prep(args, wsl, l, u, lds, tidl); }
            SEAM(pb + 4);
            if (IN(pb + 5)) {
                FRESH(); const int lane = tidl & 63, wave = __builtin_amdgcn_readfirstlane(tidl >> 6), gw = blk * NWAVES + wave, ngw = G * NWAVES;
                if (blk < 24) { dn_scan_wg2(wsl, blk >> 1, blk & 1, lds, tidl); }
                if (blk >= 24) for (int wu = (blk - 24) * NWAVES + wave; wu < 4096; wu += (G - 24) * NWAVES) ssm_final_unit(args, wsl, l, wu, lds + wave * SSM_WLDS, lane);
                __syncthreads();
                if (blk >= 24) for (int u = blk - 24; u < 1152; u += G - 24) attn_unit_mfma(args, wsl, u, lds, tidl);
                conv_slot(args, wsl, l + 1, l * 3 + 2, (unsigned)G, lds, MISC, tidl);
            }
            SEAM(pb + 5);
            if (IN(pb + 6)) {
                if (blk >= 64) { FRESH(); for (int u = blk - 64; u < 768; u += G - 64) dn_out_unit(wsl, u, tidl); }
                FRESH(); pg8::Gemm g{(const bf16_t*)(wsl + WS_YGB), (const bf16_t*)(wsl + WS_WGLU) + (size_t)l * 512 * 512, M, 512, 512}; GemmOrder S; S.init(M, 512, G, blk);
                pg8::EpiF32 E{(float*)(wsl + WS_Z), 512};
                pg8::gemm_phase<pg8::EpiF32, GemmOrder, true, true>(lds, g, S, E, tidl);
            }
            SEAM(pb + 6);
            if (IN(pb + 7)) { FRESH(); mix_phase(args, wsl, l, blk, G, tidl);
            }
            SEAM(pb + 7);
            if (IN(pb + 8)) {
                FRESH(); pg8::Gemm g{(const bf16_t*)(wsl + WS_MIX), (const bf16_t*)(wsl + WS_WOUT) + (size_t)l * D * D, M, D, D}; GemmOrder S; S.init(M, D, G, blk);
                pg8::EpiBf16P E{(bf16_t*)(wsl + WS_Y), D};
                pg8::gemm_phase<pg8::EpiBf16P, GemmOrder, true, true>(lds, g, S, E, tidl);
            }
            SEAM(pb + 8);
            if (IN(pb + 9)) { FRESH(); bf16_t* X = (bf16_t*)(wsl + WS_X); thin_phase<false, false>(X, X, (const bf16_t*)(wsl + WS_Y), gains + 3 * D, 1.0f, gains + 4 * D, (bf16_t*)(wsl + WS_H), blk, G, tidl); }
            SEAM(pb + 9);
        }
    }
#undef IN
#undef SEAM
}

#ifndef MK_ONE_LAUNCH
#define MK_ONE_LAUNCH 1
#endif
extern "C" void kernel_launch(void* const* d_in, const int* in_sizes, int n_in, void* d_out, int out_size, void* d_ws, size_t ws_size, hipStream_t stream) {
    static int grid = 0;
    if (grid == 0) {
        if (n_in != N_IN || in_sizes[0] != M * D || out_size != M * D || ws_size < WS_END) { fprintf(stderr, "kernel_launch: unexpected shapes (n_in %d, in0 %d, out %d, ws %zu, need %zu)\n", n_in, n_in > 0 ? in_sizes[0] : -1, out_size, ws_size, (size_t)WS_END); grid = -1; return; }
        int dev = 0, cus = 0, per_cu = 0;
        if (hipGetDevice(&dev) != hipSuccess || hipDeviceGetAttribute(&cus, hipDeviceAttributeMultiprocessorCount, dev) != hipSuccess) { grid = -1; return; }
        if (hipFuncSetAttribute((const void*)fwd_kernel, hipFuncAttributeMaxDynamicSharedMemorySize, LDS_BYTES) != hipSuccess) { fprintf(stderr, "kernel_launch: hipFuncSetAttribute failed\n"); grid = -1; return; }
        if (hipOccupancyMaxActiveBlocksPerMultiprocessor(&per_cu, (const void*)fwd_kernel, NTHR, LDS_BYTES) != hipSuccess || per_cu < 1) fprintf(stderr, "kernel_launch: occupancy query reports %d\n", per_cu);
        (void)hipGetLastError();
        if (cus != 256) { fprintf(stderr, "kernel_launch: built for a 256-CU device (got %d)\n", cus); grid = -1; return; }
        grid = cus;
    }
    if (grid < 0) return;
    (void)hipMemsetAsync((char*)d_ws + WS_CTL, 0, CTL_ZERO_BYTES, stream);
    Args a{};
    for (int i = 0; i < N_IN; ++i) a.in[i] = (const float*)d_in[i];
    a.out = (float*)d_out; a.ws = (unsigned char*)d_ws;
#if MK_ONE_LAUNCH
    a.ph_lo = 0; a.ph_hi = NPH;
    hipLaunchKernelGGL(fwd_kernel, dim3(grid), dim3(NTHR), LDS_BYTES, stream, a);
#else
    for (int p = 0; p < NPH; ++p) { a.ph_lo = p; a.ph_hi = p + 1; hipLaunchKernelGGL(fwd_kernel, dim3(grid), dim3(NTHR), LDS_BYTES, stream, a); }
#endif
}
```

```cpp
#include <hip/hip_runtime.h>
#include <cstdio>
#include <cstdint>
namespace pg8 {
#define PG8_LAS __attribute__((address_space(3)))
typedef unsigned short bf16_t;
typedef short bf16x8 __attribute__((ext_vector_type(8)));
typedef float f32x4 __attribute__((ext_vector_type(4)));
typedef unsigned u32x4 __attribute__((ext_vector_type(4)));
constexpr int BM = 256, BK = 64, HALF = 128, HTB = HALF * BK * 2  , STAGE_BYTES = 8 * HTB, NXCD = 8, WGM = 8;

__host__ __device__ __forceinline__ int lds_byte(int r, int c) { const int st = (r >> 4) * 2 + (c >> 5), rr = r & 15, cc = c & 31, ob = rr * 64 + cc * 2; return st * 1024 + (ob ^ (((ob >> 9) & 1) << 5)); }
__host__ __device__ __forceinline__ void stage_rc(int b, int& R, int& C) { const int st = b / 1024, sb = b % 1024, swz = sb ^ (((sb >> 9) & 1) << 5); R = (st >> 1) * 16 + swz / 64; C = (st & 1) * 32 + (swz % 64) / 2; }
__host__ __device__ __forceinline__ int perm32(int rho) { const int n = rho >> 4, i = rho & 15; return 8 * (i >> 2) + 4 * n + (i & 3); }

struct Unit { int pm, pn; };
struct Gemm { const bf16_t* A; const bf16_t* Bt; int M, N, K; };

struct StaticOrder {
    int nM, nN, nwg, G, c;
    __host__ __device__ void init(int M, int N, int G_, int c_) { nM = M / BM; nN = N / BM; nwg = nM * nN; G = G_; c = c_; }
    __host__ __device__ bool next(int i, Unit& u) const {
        const long L = (long)i * G + c; if (L >= nwg) return false;
        int wgid = (int)L; { const int q = nwg / NXCD, r = nwg % NXCD, xcd = wgid % NXCD, off = wgid / NXCD; wgid = (xcd < r ? xcd * (q + 1) : r * (q + 1) + (xcd - r) * q) + off; }
        const int nig = WGM * nN, gid = wgid / nig, fm = gid * WGM, gsz = (nM - fm) < WGM ? (nM - fm) : WGM;
        u.pm = fm + ((wgid % nig) % gsz); u.pn = (wgid % nig) / gsz; return true;
    }
    __device__ __forceinline__ void a_ready(const Unit&) const {}
    __device__ __forceinline__ void done(const Unit&) const {}
};

typedef float f32x2c __attribute__((ext_vector_type(2))); typedef __bf16 bf16x2c __attribute__((ext_vector_type(2)));
__device__ __forceinline__ unsigned cvt_pk_bf16(float lo, float hi) { const f32x2c v = {lo, hi}; return __builtin_bit_cast(unsigned, __builtin_convertvector(v, bf16x2c)); }
struct EpiF32 {
    static constexpr bool PERM = false, AFTER_DRAIN = false;
    float* C; int ldc;
    __device__ __forceinline__ void operator()(const f32x4 (&acc)[2][2][4][2], const Unit& u, int wr, int wc, int fr, int fq) const {
        const int row0 = u.pm * BM + wr * 64 + fr, col0 = u.pn * BM + wc * 32 + 4 * fq;
#pragma unroll
        for (int ai = 0; ai < 2; ++ai)
#pragma unroll
            for (int m = 0; m < 4; ++m) { float* rowp = C + (size_t)(row0 + ai * HALF + m * 16) * ldc + col0;
#pragma unroll
                for (int bj = 0; bj < 2; ++bj)
#pragma unroll
                    for (int n = 0; n < 2; ++n) *(f32x4*)(rowp + bj * HALF + n * 16) = acc[ai][bj][m][n]; }
    }
};
struct EpiBf16PS {
    static constexpr bool PERM = true, AFTER_DRAIN = false;
    bf16_t* O; int ldc; const PG8_LAS float* rs; int pm0;
    __device__ __forceinline__ void operator()(const f32x4 (&acc)[2][2][4][2], const Unit& u, int wr, int wc, int fr, int fq) const {
        const int row0 = u.pm * BM + wr * 64 + fr, col0 = u.pn * BM + wc * 32 + 8 * fq;
#pragma unroll
        for (int ai = 0; ai < 2; ++ai)
#pragma unroll
            for (int m = 0; m < 4; ++m) { bf16_t* rowp = O + (size_t)(row0 + ai * HALF + m * 16) * ldc + col0; const float s = rs[row0 - pm0 * BM + ai * HALF + m * 16];
#pragma unroll
                for (int bj = 0; bj < 2; ++bj) { const f32x4 v0 = acc[ai][bj][m][0] * s, v1 = acc[ai][bj][m][1] * s;
                    u32x4 w; w.x = cvt_pk_bf16(v0[0], v0[1]); w.y = cvt_pk_bf16(v0[2], v0[3]); w.z = cvt_pk_bf16(v1[0], v1[1]); w.w = cvt_pk_bf16(v1[2], v1[3]);
                    *(u32x4*)(rowp + bj * HALF) = w; } asm volatile("" ::: "memory"); }
    }
};
struct EpiBf16P {
    static constexpr bool PERM = true, AFTER_DRAIN = false;
    bf16_t* O; int ldc;
    __device__ __forceinline__ void operator()(const f32x4 (&acc)[2][2][4][2], const Unit& u, int wr, int wc, int fr, int fq) const {
        const int row0 = u.pm * BM + wr * 64 + fr, col0 = u.pn * BM + wc * 32 + 8 * fq;
#pragma unroll
        for (int ai = 0; ai < 2; ++ai)
#pragma unroll
            for (int m = 0; m < 4; ++m) { bf16_t* rowp = O + (size_t)(row0 + ai * HALF + m * 16) * ldc + col0;
#pragma unroll
                for (int bj = 0; bj < 2; ++bj) { const f32x4 v0 = acc[ai][bj][m][0], v1 = acc[ai][bj][m][1];
                    u32x4 w; w.x = cvt_pk_bf16(v0[0], v0[1]); w.y = cvt_pk_bf16(v0[2], v0[3]); w.z = cvt_pk_bf16(v1[0], v1[1]); w.w = cvt_pk_bf16(v1[2], v1[3]);
                    *(u32x4*)(rowp + bj * HALF) = w; } }
    }
};
struct EpiSwiGLU {
    static constexpr bool PERM = true, AFTER_DRAIN = false;
    bf16_t* O; int ldc; const PG8_LAS float* rs; int pm0;
    __device__ __forceinline__ static float silu_mul(float g, float u) { return g * u * __builtin_amdgcn_rcpf(1.0f + __builtin_amdgcn_exp2f(-1.44269504089f * g)); }
    __device__ __forceinline__ void operator()(const f32x4 (&acc)[2][2][4][2], const Unit& u, int wr, int wc, int fr, int fq) const {
        const int row0 = u.pm * BM + wr * 64 + fr, col0 = u.pn * HALF + wc * 32 + 8 * fq;
#pragma unroll
        for (int ai = 0; ai < 2; ++ai)
#pragma unroll
            for (int m = 0; m < 4; ++m) { bf16_t* rowp = O + (size_t)(row0 + ai * HALF + m * 16) * ldc + col0; const float s = rs[row0 - pm0 * BM + ai * HALF + m * 16];
                const f32x4 g0 = acc[ai][0][m][0] * s, g1 = acc[ai][0][m][1] * s, u0 = acc[ai][1][m][0] * s, u1 = acc[ai][1][m][1] * s;
                u32x4 w; w.x = cvt_pk_bf16(silu_mul(g0[0], u0[0]), silu_mul(g0[1], u0[1])); w.y = cvt_pk_bf16(silu_mul(g0[2], u0[2]), silu_mul(g0[3], u0[3]));
                w.z = cvt_pk_bf16(silu_mul(g1[0], u1[0]), silu_mul(g1[1], u1[1])); w.w = cvt_pk_bf16(silu_mul(g1[2], u1[2]), silu_mul(g1[3], u1[3]));
                *(u32x4*)rowp = w; asm volatile("" ::: "memory"); }
    }
};

template <class Epi, class Sched, bool ALIGN_EPI = false, bool SP2 = false>
__device__ __forceinline__ void gemm_phase(PG8_LAS unsigned char* lds, const Gemm g, const Sched& S, const Epi& E, int tid_in) {
    const int tid = tid_in, wid = __builtin_amdgcn_readfirstlane(tid >> 6), lane = tid & 63, wr = wid >> 2, wc = wid & 3, fr = lane & 15, fq = lane >> 4;
    const int K = g.K, nt = K / BK;
    unsigned voffA[2], voffB[2];
#pragma unroll
    for (int i = 0; i < 2; ++i) { int R, C; stage_rc(tid * 16 + i * 8192, R, C); const int Rb = Epi::PERM ? ((R & ~31) + perm32(R & 31)) : R;
        voffA[i] = (unsigned)(R * K + C) * 2u; voffB[i] = (unsigned)(Rb * K + C) * 2u; }
    const size_t kstep = (size_t)(BK * 2);
    const size_t hstep = (size_t)HALF * K * 2;
    const size_t tstep = 2 * hstep;
    const unsigned ldsw = (unsigned)wid * 1024u;
    const int aoff = lds_byte(wr * 64 + fr, fq * 8), boff = lds_byte(wc * 32 + fr, fq * 8);
#define PG8_SA(b, h) (((b) * 2 + (h)) * HTB)
#define PG8_SB(b, h) ((4 + (b) * 2 + (h)) * HTB)
#define PG8_STAGE(bufoff, gbase, voff) do { _Pragma("unroll") for (int _i = 0; _i < 2; ++_i) \
        __builtin_amdgcn_global_load_lds((const unsigned*)((const char*)(gbase) + (voff)[_i]), (PG8_LAS unsigned*)(lds + (bufoff) + ldsw + _i * 8192), 16, 0, 0); } while (0)
#define PG8_LDA(dst, b, h) do { _Pragma("unroll") for (int m = 0; m < 4; ++m) _Pragma("unroll") for (int k = 0; k < 2; ++k) dst[m][k] = *(const PG8_LAS bf16x8*)(lds + PG8_SA(b, h) + aoff + m * 2048 + k * 1024); } while (0)
#define PG8_LDB(dst, b, h) do { _Pragma("unroll") for (int n = 0; n < 2; ++n) _Pragma("unroll") for (int k = 0; k < 2; ++k) dst[n][k] = *(const PG8_LAS bf16x8*)(lds + PG8_SB(b, h) + boff + n * 2048 + k * 1024); } while (0)
#define PG8_MMA(ai, bj, At, Bt) do { __builtin_amdgcn_s_setprio(1); _Pragma("unroll") for (int m = 0; m < 4; ++m) _Pragma("unroll") for (int n = 0; n < 2; ++n) _Pragma("unroll") for (int k = 0; k < 2; ++k) \
        acc[ai][bj][m][n] = __builtin_amdgcn_mfma_f32_16x16x32_bf16(Bt[n][k], At[m][k], acc[ai][bj][m][n], 0, 0, 0); __builtin_amdgcn_s_setprio(0); } while (0)
#define PG8_WAIT_V(n) asm volatile("s_waitcnt vmcnt(" #n ")" ::: "memory")
#define PG8_WAIT_L(n) asm volatile("s_waitcnt lgkmcnt(" #n ")" ::: "memory")
#define PG8_BAR __builtin_amdgcn_s_barrier()
#define PG8_SCHED __builtin_amdgcn_sched_barrier(0)
    Unit cur, nxt; int ui = 0;
    if (!S.next(0, cur)) return;
    f32x4 acc[2][2][4][2];
#pragma unroll
    for (int a = 0; a < 2; ++a)
#pragma unroll
        for (int b = 0; b < 2; ++b)
#pragma unroll
            for (int m = 0; m < 4; ++m)
#pragma unroll
                for (int n = 0; n < 2; ++n) acc[a][b][m][n] = (f32x4){0.f, 0.f, 0.f, 0.f};
    bf16x8 At[4][2], B0[2][2], B1[2][2];
    const char* cA = (const char*)g.A + (size_t)cur.pm * tstep; const char* cB = (const char*)g.Bt + (size_t)cur.pn * tstep;
    S.a_ready(cur);
    if constexpr (SP2) {
        PG8_STAGE(PG8_SB(0, 0), cB, voffB); PG8_STAGE(PG8_SB(0, 1), cB + hstep, voffB); PG8_STAGE(PG8_SA(0, 0), cA, voffA); PG8_STAGE(PG8_SA(0, 1), cA + hstep, voffA);
        if (wr == 1) PG8_BAR;
        PG8_WAIT_V(2); PG8_BAR;
        PG8_STAGE(PG8_SB(1, 0), cB + kstep, voffB); PG8_STAGE(PG8_SA(1, 0), cA + kstep, voffA); PG8_STAGE(PG8_SB(1, 1), cB + hstep + kstep, voffB);
        PG8_WAIT_V(6); PG8_BAR;
    } else {
        PG8_STAGE(PG8_SB(0, 0), cB, voffB); PG8_STAGE(PG8_SA(0, 0), cA, voffA); PG8_STAGE(PG8_SB(0, 1), cB + hstep, voffB); PG8_STAGE(PG8_SA(0, 1), cA + hstep, voffA);
        if (wr == 1) PG8_BAR;
        PG8_WAIT_V(4); PG8_BAR;
        PG8_STAGE(PG8_SB(1, 0), cB + kstep, voffB); PG8_STAGE(PG8_SA(1, 0), cA + kstep, voffA); PG8_STAGE(PG8_SB(1, 1), cB + hstep + kstep, voffB);
        PG8_WAIT_V(6); PG8_BAR;
    }
    for (;;) {
        const bool has_next = S.next(ui + 1, nxt);
        const char* nA = has_next ? (const char*)g.A + (size_t)nxt.pm * tstep : cA; const char* nB = has_next ? (const char*)g.Bt + (size_t)nxt.pn * tstep : cB;
        for (int t = 0; t < nt; t += 2) {
            const bool last = (t == nt - 2);
            const char* a1 = cA + (size_t)(t + 1) * kstep;
            const char* a2 = last ? nA : cA + (size_t)(t + 2) * kstep; const char* b2 = last ? nB : cB + (size_t)(t + 2) * kstep;
            const char* a3 = a2 + kstep; const char* b3 = b2 + kstep;
            if (last && has_next) S.a_ready(nxt);
            if constexpr (SP2) {
            PG8_LDB(B0, 0, 0); PG8_LDB(B1, 0, 1); PG8_SCHED; PG8_LDA(At, 0, 0); PG8_STAGE(PG8_SA(1, 1), a1 + hstep, voffA);
            PG8_WAIT_V(8); PG8_WAIT_L(0); PG8_BAR; PG8_MMA(0, 0, At, B0); PG8_MMA(0, 1, At, B1); PG8_BAR; PG8_SCHED;
            PG8_LDA(At, 0, 1); PG8_STAGE(PG8_SB(0, 0), b2, voffB); PG8_STAGE(PG8_SB(0, 1), b2 + hstep, voffB); PG8_STAGE(PG8_SA(0, 0), a2, voffA);
            PG8_WAIT_V(8); PG8_WAIT_L(0); PG8_BAR; PG8_MMA(1, 0, At, B0); PG8_MMA(1, 1, At, B1); PG8_BAR; PG8_SCHED;
            PG8_LDB(B0, 1, 0); PG8_LDB(B1, 1, 1); PG8_SCHED; PG8_LDA(At, 1, 0); PG8_STAGE(PG8_SA(0, 1), a2 + hstep, voffA);
            PG8_WAIT_V(8); PG8_WAIT_L(0); PG8_BAR; PG8_MMA(0, 0, At, B0); PG8_MMA(0, 1, At, B1); PG8_BAR; PG8_SCHED;
            PG8_LDA(At, 1, 1); PG8_STAGE(PG8_SB(1, 0), b3, voffB); PG8_STAGE(PG8_SB(1, 1), b3 + hstep, voffB); PG8_STAGE(PG8_SA(1, 0), a3, voffA);
            PG8_WAIT_V(8); PG8_WAIT_L(0); PG8_BAR; PG8_MMA(1, 0, At, B0); PG8_MMA(1, 1, At, B1); PG8_BAR; PG8_SCHED;
            } else {
            PG8_LDB(B0, 0, 0); PG8_SCHED; PG8_LDA(At, 0, 0); PG8_STAGE(PG8_SA(1, 1), a1 + hstep, voffA);
            PG8_WAIT_L(8); PG8_BAR; PG8_WAIT_L(0); PG8_MMA(0, 0, At, B0); PG8_BAR; PG8_SCHED;
            PG8_LDB(B1, 0, 1); PG8_STAGE(PG8_SB(0, 0), b2, voffB);
            PG8_BAR; PG8_WAIT_L(0); PG8_MMA(0, 1, At, B1); PG8_BAR;
            PG8_LDA(At, 0, 1); PG8_STAGE(PG8_SA(0, 0), a2, voffA);
            PG8_BAR; PG8_WAIT_L(0); PG8_MMA(1, 0, At, B0); PG8_BAR; PG8_SCHED;
            PG8_STAGE(PG8_SB(0, 1), b2 + hstep, voffB);
            PG8_WAIT_V(6); PG8_BAR; PG8_MMA(1, 1, At, B1); PG8_BAR;
            PG8_LDB(B0, 1, 0); PG8_SCHED; PG8_LDA(At, 1, 0); PG8_STAGE(PG8_SA(0, 1), a2 + hstep, voffA);
            PG8_WAIT_L(8); PG8_BAR; PG8_WAIT_L(0); PG8_MMA(0, 0, At, B0); PG8_BAR; PG8_SCHED;
            PG8_LDB(B1, 1, 1); PG8_STAGE(PG8_SB(1, 0), b3, voffB);
            PG8_BAR; PG8_WAIT_L(0); PG8_MMA(0, 1, At, B1); PG8_BAR;
            PG8_LDA(At, 1, 1); PG8_STAGE(PG8_SA(1, 0), a3, voffA);
            PG8_BAR; PG8_WAIT_L(0); PG8_MMA(1, 0, At, B0); PG8_BAR; PG8_SCHED;
            PG8_STAGE(PG8_SB(1, 1), b3 + hstep, voffB);
            PG8_WAIT_V(6); PG8_BAR; PG8_MMA(1, 1, At, B1); PG8_BAR;
            }
        }
        if constexpr (ALIGN_EPI) { if (wr == 0) PG8_BAR; }
        if constexpr (!Epi::AFTER_DRAIN) { E(acc, cur, wr, wc, fr, fq); S.done(cur); }
        if (!has_next) break;
#pragma unroll
        for (int a = 0; a < 2; ++a)
#pragma unroll
            for (int b = 0; b < 2; ++b)
#pragma unroll
                for (int m = 0; m < 4; ++m)
#pragma unroll
                    for (int n = 0; n < 2; ++n) acc[a][b][m][n] = (f32x4){0.f, 0.f, 0.f, 0.f};
        cur = nxt; cA = nA; cB = nB; ++ui;
        if constexpr (ALIGN_EPI) { if (wr == 1) PG8_BAR; }
    }
    PG8_WAIT_V(0);
    if constexpr (!ALIGN_EPI) { if (wr == 0) PG8_BAR; }
    PG8_BAR;
    if constexpr (Epi::AFTER_DRAIN) { E.fused(acc, cur, wr, wc, fr, fq, lds, wid, lane); S.done(cur); }
#undef PG8_SA
#undef PG8_SB
#undef PG8_STAGE
#undef PG8_LDA
#undef PG8_LDB
#undef PG8_MMA
#undef PG8_WAIT_V
#undef PG8_WAIT_L
#undef PG8_BAR
#undef PG8_SCHED
}
}

#define LAS __attribute__((address_space(3)))
typedef unsigned short bf16_t;
typedef float f32x4 __attribute__((ext_vector_type(4)));
typedef float f32x2 __attribute__((ext_vector_type(2)));
typedef unsigned u32x4 __attribute__((ext_vector_type(4)));
typedef unsigned u32x2 __attribute__((ext_vector_type(2)));
constexpr int NWAVES = 8, NTHR = 512;
constexpr int D = 2048, SEQ = 4096, M = 8192, DEPTH = 4, DFF = 5632, NGU = 2 * DFF, NIN = 5900, NINP = 6144;
constexpr int PC_SSM = 0, PC_AQ = 512, PC_AK = 1280, PC_AV = 2048, PC_DQKV = 2816, PC_DZ = 5120, PC_DA = 5888, PC_DB = 5894;
constexpr float EPS = 1e-6f;
enum { I_X = 0, I_GAINS, I_WG, I_WU, I_WD, I_WIN, I_WOUT, I_LRE, I_LIM, I_BRE, I_BIM, I_CRE, I_CIM, I_SD, I_LOGDT, I_GLUW, I_GLUB, I_SGAIN, I_CONVW, I_ALOG, I_DTB, I_DNG, I_ATG, I_RELB, N_IN };
constexpr size_t MiB = 1ull << 20;
constexpr size_t WS_CTL = 0, CTL_ZERO_BYTES = 1 * MiB;
constexpr size_t WS_WGU = 1 * MiB;
constexpr size_t WS_WD = WS_WGU + 352 * MiB;
constexpr size_t WS_WIN = WS_WD + 176 * MiB;
constexpr size_t WS_WOUT = WS_WIN + 96 * MiB;
constexpr size_t WS_WGLU = WS_WOUT + 32 * MiB;
constexpr size_t WS_X = WS_WGLU + 2 * MiB;
constexpr size_t WS_H = WS_X + 64 * MiB;
constexpr size_t WS_RS = WS_H;
constexpr size_t WS_ACT = WS_H + 32 * MiB;
constexpr size_t WS_Y = WS_ACT + 88 * MiB;
constexpr size_t WS_PROJ = WS_Y + 64 * MiB;
constexpr size_t WS_MIX = WS_PROJ + 192 * MiB;
constexpr size_t WS_SSME = WS_MIX + 32 * MiB;
constexpr size_t WS_YG = WS_SSME + 2 * MiB;
constexpr size_t WS_YGB = WS_YG + 16 * MiB;
constexpr size_t WS_Z = WS_YGB + 8 * MiB;
constexpr size_t WS_DQ = WS_Z + 16 * MiB;
constexpr size_t WS_DK = WS_DQ + 24 * MiB;
constexpr size_t WS_DV = WS_DK + 24 * MiB;
constexpr size_t WS_DO = WS_DV + 24 * MiB;
constexpr size_t WS_DBG = WS_DO + 24 * MiB;
constexpr size_t WS_DWN = WS_DQ;
constexpr size_t WS_DQD = WS_DWN + 12 * MiB;
constexpr size_t WS_DKT = WS_DQD + 12 * MiB;
constexpr size_t WS_DAT = WS_DKT + 12 * MiB;
constexpr size_t WS_DUD = WS_DAT + 6 * MiB;
constexpr size_t WS_DCD = WS_DUD + 24 * MiB;
static_assert(WS_DCD + 1 * MiB <= WS_DO, "DN overlay");
constexpr size_t WS_AO = WS_DBG + 1 * MiB;
constexpr size_t WS_ALSE = WS_AO + 72 * MiB;
constexpr size_t WS_DSS = WS_ALSE + 1 * MiB;
constexpr size_t WS_DVN = WS_DSS + 24 * MiB;
constexpr size_t WS_END = WS_DVN + 12 * MiB;
constexpr int CW_BAR = 4096;
constexpr int LDS_BYTES = 155648, MISC_OFF = LDS_BYTES - 256;

#define XB_TMO      128
#define XB_XCNT(j)  (256  + 64 * (j))
#define XB_XSUB(j)  (1280 + 64 * (j))
#define XB_XGEN(j)  (2304 + 64 * (j))
#define XB_TOP      3328
#define XB_TOPGEN   3392
#define XCD_BAR_WORDS 3456
#define XB_SPIN_CAP (1u << 18)

__device__ __forceinline__ unsigned xb_ld(unsigned* p)              { return __hip_atomic_load(p, __ATOMIC_RELAXED, __HIP_MEMORY_SCOPE_AGENT); }
__device__ __forceinline__ unsigned xb_add(unsigned* p, unsigned v) { return __hip_atomic_fetch_add(p, v, __ATOMIC_RELAXED, __HIP_MEMORY_SCOPE_AGENT); }
__device__ __forceinline__ unsigned xb_xcc_id() { return (unsigned)__builtin_amdgcn_s_getreg((3 << 11) | 20) & 0xFu; }
#define XB_SPIN(cond, bar) do { unsigned _sp = 0; while (cond) { __builtin_amdgcn_s_sleep(1); \
    if ((++_sp & 255u) == 0u) { if (xb_ld(&(bar)[XB_TMO])) break; if (_sp > XB_SPIN_CAP) { atomicAdd(&(bar)[XB_TMO], 1u); break; } } } } while (0)

struct XcdBarrier {
    unsigned* bar; unsigned x;
    volatile LAS unsigned* st;
};

__device__ __forceinline__ XcdBarrier xcd_barrier_post(unsigned* bar, volatile LAS unsigned* st) {
    XcdBarrier b; b.bar = bar; b.x = xb_xcc_id(); b.st = st;
    if (threadIdx.x == 0) (void)xb_add(&bar[XB_XCNT(b.x)], 1u);
    return b;
}
__device__ __forceinline__ void xcd_barrier_complete(unsigned* bar, unsigned x, unsigned& nloc, unsigned& nx) {
    const unsigned G = gridDim.x * gridDim.y * gridDim.z;
    unsigned sum, cnt, mine, sp = 0u;
    for (;;) {
        sum = 0u; cnt = 0u; mine = 0u;
#pragma unroll
        for (unsigned j = 0; j < 16; ++j) { const unsigned c = xb_ld(&bar[XB_XCNT(j)]); sum += c; cnt += (c > 0u) ? 1u : 0u; mine = (j == x) ? c : mine; }
        if (sum == G) break;
        __builtin_amdgcn_s_sleep(1);
        if ((++sp & 255u) == 0u) { if (xb_ld(&bar[XB_TMO])) break; if (sp > XB_SPIN_CAP) { atomicAdd(&bar[XB_TMO], 1u); break; } }
    }
    nloc = mine > 0u ? mine : 1u; nx = cnt > 0u ? cnt : 1u;
}

__device__ __forceinline__ void xcd_barrier(const XcdBarrier& b) {
    asm volatile("s_waitcnt vmcnt(0)" ::: "memory");
    __syncthreads();
    if (threadIdx.x == 0) {
        unsigned bz_ = 0; asm volatile("" : "+s"(bz_)); unsigned* bar = b.bar + bz_;
        __builtin_amdgcn_s_waitcnt(0);
        unsigned nloc = b.st[0], nx = b.st[1];
        if (nloc == 0u) { xcd_barrier_complete(bar, b.x, nloc, nx); b.st[0] = nloc; b.st[1] = nx; }
        const unsigned old = xb_add(&bar[XB_XSUB(b.x)], 1u);
        const unsigned gen = old / nloc;
        if (old + 1u == (gen + 1u) * nloc) {
            __builtin_amdgcn_fence(__ATOMIC_RELEASE, "agent");
            asm volatile("s_waitcnt vmcnt(0)" ::: "memory");
            const unsigned og = xb_add(&bar[XB_TOP], 1u);
            const unsigned tg = og / nx;
            if (og + 1u == (tg + 1u) * nx) xb_add(&bar[XB_TOPGEN], 1u);
            else XB_SPIN(xb_ld(&bar[XB_TOPGEN]) == tg, bar);
            __builtin_amdgcn_fence(__ATOMIC_ACQUIRE, "agent");
            xb_add(&bar[XB_XGEN(b.x)], 1u);
            asm volatile("s_waitcnt vmcnt(0)" ::: "memory");
        } else {
            XB_SPIN(xb_ld(&bar[XB_XGEN(b.x)]) == gen, bar);
            __builtin_amdgcn_fence(__ATOMIC_ACQUIRE, "agent");
            asm volatile("s_waitcnt vmcnt(0)" ::: "memory");
        }
    }
    __syncthreads();
}

struct Args { const float* in[24]; float* out; unsigned char* ws; int ph_lo, ph_hi; };
__device__ __forceinline__ float shx(int lane, float v, int o) { return __int_as_float(__builtin_amdgcn_ds_bpermute((lane ^ o) << 2, __float_as_int(v))); }
__device__ __forceinline__ float wave_sum(int lane, float v) {
#pragma unroll
    for (int o = 1; o < 64; o <<= 1) v += shx(lane, v, o);
    return v;
}
__device__ __forceinline__ float wave_max(int lane, float v) {
#pragma unroll
    for (int o = 1; o < 64; o <<= 1) v = fmaxf(v, shx(lane, v, o));
    return v;
}
__device__ __forceinline__ unsigned pk2(float lo, float hi) { return pg8::cvt_pk_bf16(lo, hi); }
__device__ __forceinline__ f32x4 zero_acc() { float z = 0.f; asm volatile("" : "+v"(z)); return (f32x4){z, z, z, z}; }
__device__ __forceinline__ float bf_lo(unsigned w) { return __uint_as_float(w << 16); }
__device__ __forceinline__ float bf_hi(unsigned w) { return __uint_as_float(w & 0xffff0000u); }
__device__ __forceinline__ float sigmoidf_(float x) { return 1.0f / (1.0f + expf(-x)); }
__device__ __forceinline__ float siluf_(float x) { return x / (1.0f + expf(-x)); }
#define LDS_WAIT() asm volatile("s_waitcnt lgkmcnt(0)" ::: "memory")

struct CvItem { const float* src; bf16_t* dst; const float* gk; int ldw, K, nvalid; };
__device__ __forceinline__ void cv_load(const CvItem& d, f32x4 (&r)[8], int lane) {
    if (d.nvalid == 32) { const int c4 = lane & 7, kr = lane >> 3;
#pragma unroll
        for (int i = 0; i < 8; ++i) r[i] = *(const f32x4*)(d.src + (size_t)(8 * i + kr) * d.ldw + 4 * c4); }
}
__device__ __forceinline__ void cv_finish(const CvItem& d, const f32x4 (&r)[8], LAS float* scr, int lane) {
    if (d.nvalid == 32) { const int c4 = lane & 7, kr = lane >> 3;
#pragma unroll
        for (int i = 0; i < 8; ++i) { const int kk = 8 * i + kr; const float gg = d.gk ? d.gk[kk] : 1.0f; scr[kk * 33 + 4 * c4] = r[i].x * gg; scr[kk * 33 + 4 * c4 + 1] = r[i].y * gg; scr[kk * 33 + 4 * c4 + 2] = r[i].z * gg; scr[kk * 33 + 4 * c4 + 3] = r[i].w * gg; } }
    else { const int c = lane & 31;
#pragma unroll 8
        for (int i = 0; i < 32; ++i) { const int kk = 2 * i + (lane >> 5); scr[kk * 33 + c] = (c < d.nvalid) ? d.src[(size_t)kk * d.ldw + c] * (d.gk ? d.gk[kk] : 1.0f) : 0.f; } }
    LDS_WAIT(); asm volatile("" ::: "memory");
    const int c8 = lane & 7;
#pragma unroll
    for (int j = 0; j < 4; ++j) { const int n = (lane >> 3) + 8 * j; const LAS float* s = scr + (8 * c8) * 33 + n;
        u32x4 o; o.x = pk2(s[0 * 33], s[1 * 33]); o.y = pk2(s[2 * 33], s[3 * 33]); o.z = pk2(s[4 * 33], s[5 * 33]); o.w = pk2(s[6 * 33], s[7 * 33]);
        *(u32x4*)(d.dst + (size_t)n * d.K + 8 * c8) = o; }
    LDS_WAIT(); asm volatile("" ::: "memory");
}
__device__ __forceinline__ void rowscale_bf16(const float* xrow, bf16_t* orow, float* rs, int lane) {
    f32x4 v[8]; float ss = 0.f;
#pragma unroll
    for (int j = 0; j < 8; ++j) { v[j] = ((const f32x4*)xrow)[lane + 64 * j]; ss += (v[j].x * v[j].x + v[j].y * v[j].y) + (v[j].z * v[j].z + v[j].w * v[j].w); }
    const float r = rsqrtf(wave_sum(lane, ss) * (1.f / D) + EPS);
#pragma unroll
    for (int j = 0; j < 8; ++j) { u32x2 w; w.x = pk2(v[j].x, v[j].y); w.y = pk2(v[j].z, v[j].w); ((u32x2*)orow)[lane + 64 * j] = w; }
    if (lane == 0) *rs = r;
}
constexpr int CV_GU = 2 * 352 * 32, CV_D = 2 * 64 * 88, CV_IN = 192 * 32, CV_OUT = 64 * 32, CV_GLU = 16 * 8, CV_ITEMS = CV_GU + CV_D + CV_IN + CV_OUT + CV_GLU;
__device__ __forceinline__ CvItem cv_decode(const Args& a, unsigned char* ws, int L, int it) {
    int r = it; CvItem d;
    if (r < CV_GU) { const int mi = L * 2 + r / (352 * 32), q = r % (352 * 32), kb = q / 352, ng = q % 352, nd0 = 32 * ng, pn = nd0 >> 8, wi = nd0 & 255, bj = wi >> 7, i = wi & 127;
        d.src = (bj ? a.in[I_WU] : a.in[I_WG]) + (size_t)mi * D * DFF + (size_t)(64 * kb) * DFF + 128 * pn + i; d.ldw = DFF; d.nvalid = 32; d.gk = a.in[I_GAINS] + (size_t)(L * 6 + ((mi & 1) ? 4 : 0)) * D + 64 * kb;
        d.dst = (bf16_t*)(ws + WS_WGU) + (size_t)mi * NGU * D + (size_t)nd0 * D + 64 * kb; d.K = D; return d; }
    r -= CV_GU;
    if (r < CV_D) { const int mi = L * 2 + r / (64 * 88), q = r % (64 * 88), kb = q / 64, ng = q % 64;
        d.src = a.in[I_WD] + (size_t)mi * DFF * D + (size_t)(64 * kb) * D + 32 * ng; d.ldw = D; d.nvalid = 32; d.gk = nullptr;
        d.dst = (bf16_t*)(ws + WS_WD) + (size_t)mi * D * DFF + (size_t)(32 * ng) * DFF + 64 * kb; d.K = DFF; return d; }
    r -= CV_D;
    if (r < CV_IN) { const int kb = r / 192, ng = r % 192; int nv = NIN - 32 * ng; nv = nv > 32 ? 32 : (nv < 0 ? 0 : nv);
        d.src = a.in[I_WIN] + (size_t)L * D * NIN + (size_t)(64 * kb) * NIN + 32 * ng; d.ldw = NIN; d.nvalid = nv; d.gk = a.in[I_GAINS] + (size_t)(L * 6 + 2) * D + 64 * kb;
        d.dst = (bf16_t*)(ws + WS_WIN) + (size_t)L * NINP * D + (size_t)(32 * ng) * D + 64 * kb; d.K = D; return d; }
    r -= CV_IN;
    if (r < CV_OUT) { const int kb = r / 64, ng = r % 64;
        d.src = a.in[I_WOUT] + (size_t)L * D * D + (size_t)(64 * kb) * D + 32 * ng; d.ldw = D; d.nvalid = 32; d.gk = nullptr;
        d.dst = (bf16_t*)(ws + WS_WOUT) + (size_t)L * D * D + (size_t)(32 * ng) * D + 64 * kb; d.K = D; return d; }
    r -= CV_OUT;
    { const int kb = r / 16, ng = r % 16;
        d.src = a.in[I_GLUW] + (size_t)L * 512 * 512 + (size_t)(64 * kb) * 512 + 32 * ng; d.ldw = 512; d.nvalid = 32; d.gk = nullptr;
        d.dst = (bf16_t*)(ws + WS_WGLU) + (size_t)L * 512 * 512 + (size_t)(32 * ng) * 512 + 64 * kb; d.K = 512; return d; }
}
__device__ __forceinline__ void cv_run(const Args& a, unsigned char* ws, int L, int first, int stride, int count, LAS float* scr, int lane) {
    if (count <= 0 || first >= CV_ITEMS) return;
    CvItem cur = cv_decode(a, ws, L, first); f32x4 r0[8], r1[8];
    cv_load(cur, r0, lane);
    for (int j = 0; j < count; ++j) {
        const int nit = first + (j + 1) * stride; const bool more = (j + 1 < count) && (nit < CV_ITEMS);
        CvItem nx = cur;
        if (more) { nx = cv_decode(a, ws, L, nit); cv_load(nx, r1, lane); }
        cv_finish(cur, r0, scr, lane);
        if (!more) break;
        cur = nx;
#pragma unroll
        for (int i = 0; i < 8; ++i) r0[i] = r1[i];
    }
}
__device__ __forceinline__ void p0_prologue(const Args& a, unsigned char* ws, LAS unsigned char* lds, int blk, int G, int tid) {
    const int lane = tid & 63, wave = __builtin_amdgcn_readfirstlane(tid >> 6), gw = blk * NWAVES + wave, ngw = G * NWAVES;
    LAS float* scr = (LAS float*)(lds + wave * 16384);
    cv_run(a, ws, 0, gw, ngw, (CV_ITEMS + ngw - 1) / ngw, scr, lane);
    for (int m = gw; m < M; m += ngw) rowscale_bf16(a.in[I_X] + (size_t)m * D, (bf16_t*)(ws + WS_X) + (size_t)m * D, (float*)(ws + WS_RS) + m, lane);
}
constexpr int CW_Q = 8192, CW_DONE = 8192 + 64 * 8;
__device__ __forceinline__ void conv_slot(const Args& a, unsigned char* ws, int L, int slot, unsigned target, LAS unsigned char* lds, volatile LAS unsigned* MISC, int tid) {
    if (L >= DEPTH) return;
    const int lane = tid & 63, wave = __builtin_amdgcn_readfirstlane(tid >> 6);
    unsigned* q = (unsigned*)(ws + WS_CTL) + CW_Q + 64 * L; unsigned* dn = (unsigned*)(ws + WS_CTL) + CW_DONE + 64 * slot;
    LAS float* scr = (LAS float*)(lds + wave * 16384);
    __syncthreads();
    if (target && tid == 0) __hip_atomic_fetch_add(dn, 1u, __ATOMIC_RELAXED, __HIP_MEMORY_SCOPE_AGENT);
    const unsigned nb = target ? 2u : 8u;
    for (;;) {
        if (tid == 0) { unsigned base = 0xffffffffu;
            if (!target || __hip_atomic_load(dn, __ATOMIC_RELAXED, __HIP_MEMORY_SCOPE_AGENT) < target) base = __hip_atomic_fetch_add(q, 8u * nb, __ATOMIC_RELAXED, __HIP_MEMORY_SCOPE_AGENT);
            MISC[16] = base; }
        __syncthreads();
        const unsigned base = MISC[16];
        __syncthreads();
        if (base >= (unsigned)CV_ITEMS) break;
        cv_run(a, ws, L, (int)base + wave, 8, (int)nb, scr, lane);
    }
}

__device__ __forceinline__ void bf8_to_f32(const u32x4 w, float (&o)[8]) { o[0] = bf_lo(w.x); o[1] = bf_hi(w.x); o[2] = bf_lo(w.y); o[3] = bf_hi(w.y); o[4] = bf_lo(w.z); o[5] = bf_hi(w.z); o[6] = bf_lo(w.w); o[7] = bf_hi(w.w); }
template <bool SRC_F32, bool DST_F32>
__device__ __forceinline__ void thin_phase(const void* xsrc, void* xdst, const bf16_t* y, const float* gpost, float scale, float* rs, int blk, int G, int tid) {
    const int lane = tid & 63, wave = __builtin_amdgcn_readfirstlane(tid >> 6), gw = blk * NWAVES + wave, ngw = G * NWAVES;
    for (int m = gw; m < M; m += ngw) {
        float yv[4][8], xv[4][8]; float ss = 0.f;
#pragma unroll
        for (int j = 0; j < 4; ++j) { bf8_to_f32(((const u32x4*)(y + (size_t)m * D))[lane + 64 * j], yv[j]);
            if (SRC_F32) { const f32x4 a0 = ((const f32x4*)((const float*)xsrc + (size_t)m * D))[(lane + 64 * j) * 2], a1 = ((const f32x4*)((const float*)xsrc + (size_t)m * D))[(lane + 64 * j) * 2 + 1];
                xv[j][0] = a0.x; xv[j][1] = a0.y; xv[j][2] = a0.z; xv[j][3] = a0.w; xv[j][4] = a1.x; xv[j][5] = a1.y; xv[j][6] = a1.z; xv[j][7] = a1.w; }
            else bf8_to_f32(((const u32x4*)((const bf16_t*)xsrc + (size_t)m * D))[lane + 64 * j], xv[j]);
#pragma unroll
            for (int i = 0; i < 8; ++i) ss += yv[j][i] * yv[j][i]; }
        const float r1 = rsqrtf(wave_sum(lane, ss) * (1.f / D) + EPS) * scale; float s2 = 0.f;
#pragma unroll
        for (int j = 0; j < 4; ++j) { const f32x4 g0 = ((const f32x4*)gpost)[(lane + 64 * j) * 2], g1 = ((const f32x4*)gpost)[(lane + 64 * j) * 2 + 1]; const float gg[8] = {g0.x, g0.y, g0.z, g0.w, g1.x, g1.y, g1.z, g1.w};
#pragma unroll
            for (int i = 0; i < 8; ++i) { xv[j][i] += yv[j][i] * r1 * gg[i]; s2 += xv[j][i] * xv[j][i]; }
            if (DST_F32) { ((f32x4*)((float*)xdst + (size_t)m * D))[(lane + 64 * j) * 2] = (f32x4){xv[j][0], xv[j][1], xv[j][2], xv[j][3]}; ((f32x4*)((float*)xdst + (size_t)m * D))[(lane + 64 * j) * 2 + 1] = (f32x4){xv[j][4], xv[j][5], xv[j][6], xv[j][7]}; }
            else { u32x4 w; w.x = pk2(xv[j][0], xv[j][1]); w.y = pk2(xv[j][2], xv[j][3]); w.z = pk2(xv[j][4], xv[j][5]); w.w = pk2(xv[j][6], xv[j][7]); ((u32x4*)((bf16_t*)xdst + (size_t)m * D))[lane + 64 * j] = w; } }
        if (rs) { const float r2 = rsqrtf(wave_sum(lane, s2) * (1.f / D) + EPS); if (lane == 0) rs[m] = r2; }
    }
}

__device__ __forceinline__ void ssm_lambda(const Args& a, int l, int g, int p, float& ar, float& ai, float& cr, float& ci) {
    const float lr = a.in[I_LRE][(l * 32 + g) * 64 + p], li = a.in[I_LIM][(l * 32 + g) * 64 + p], dt = expf(a.in[I_LOGDT][l * 32 + g]);
    const float x = lr * dt, yy = li * dt; float sn, cs; sincosf(yy, &sn, &cs); const float mag = expf(x);
    ar = mag * cs; ai = mag * sn;
    const float sh = sinf(0.5f * yy); const float er = expm1f(x) * cs - 2.f * sh * sh, ei = ai;
    const float den = 1.f / (lr * lr + li * li); cr = (er * lr + ei * li) * den; ci = (ei * lr - er * li) * den;
}
__device__ __forceinline__ void ssm_local(const Args& a, unsigned char* ws, int l, int blk, int G, int tid, LAS unsigned char* lds) {
    const int lane = tid & 63, wave = __builtin_amdgcn_readfirstlane(tid >> 6), gw = blk * NWAVES + wave, ngw = G * NWAVES;
    const bf16_t* proj = (const bf16_t*)(ws + WS_PROJ); f32x2* E = (f32x2*)(ws + WS_SSME);
    LAS f32x4* ubuf = (LAS f32x4*)(lds + wave * 4096);
    for (int wu = gw; wu < 4096; wu += ngw) {
        const int b = wu >> 11, g = (wu >> 6) & 31, ch = wu & 63;
        const bf16_t* up = proj + (size_t)(b * SEQ + ch * 64) * NINP + PC_SSM + g * 16;
        const u32x4 ub0 = *(const u32x4*)(up + (size_t)lane * NINP), ub1 = *(const u32x4*)(up + (size_t)lane * NINP + 8);
        float ar, ai, cr, ci; ssm_lambda(a, l, g, lane, ar, ai, cr, ci);
        float bbr[16], bbi[16];
        { const f32x4* br = (const f32x4*)(a.in[I_BRE] + ((size_t)(l * 32 + g) * 64 + lane) * 16); const f32x4* bi = (const f32x4*)(a.in[I_BIM] + ((size_t)(l * 32 + g) * 64 + lane) * 16);
#pragma unroll
          for (int q = 0; q < 4; ++q) { const f32x4 x = br[q], y = bi[q];
#pragma unroll
              for (int e = 0; e < 4; ++e) { bbr[4 * q + e] = cr * x[e] - ci * y[e]; bbi[4 * q + e] = cr * y[e] + ci * x[e]; } } }
        { float t0[8], t1[8]; bf8_to_f32(ub0, t0); bf8_to_f32(ub1, t1);
          ubuf[lane * 4 + 0] = (f32x4){t0[0], t0[1], t0[2], t0[3]}; ubuf[lane * 4 + 1] = (f32x4){t0[4], t0[5], t0[6], t0[7]}; ubuf[lane * 4 + 2] = (f32x4){t1[0], t1[1], t1[2], t1[3]}; ubuf[lane * 4 + 3] = (f32x4){t1[4], t1[5], t1[6], t1[7]}; }
        LDS_WAIT(); asm volatile("" ::: "memory");
        f32x2 bb[16];
#pragma unroll
        for (int e = 0; e < 16; ++e) bb[e] = (f32x2){bbr[e], bbi[e]};
        f32x2 sv = {0.f, 0.f}; const f32x2 la = {ar, ar}, lb = {-ai, ai};
        for (int tg = 0; tg < 8; ++tg) { f32x4 ug[8][4];
#pragma unroll
            for (int tt = 0; tt < 8; ++tt)
#pragma unroll
                for (int q = 0; q < 4; ++q) ug[tt][q] = ubuf[(tg * 8 + tt) * 4 + q];
            __builtin_amdgcn_sched_barrier(0);
#pragma unroll
            for (int tt = 0; tt < 8; ++tt) { f32x2 bu0 = {0.f, 0.f}, bu1 = {0.f, 0.f};
#pragma unroll
                for (int q = 0; q < 4; ++q) { const f32x4 u = ug[tt][q];
                    bu0 += bb[4 * q + 0] * (f32x2){u[0], u[0]}; bu1 += bb[4 * q + 1] * (f32x2){u[1], u[1]}; bu0 += bb[4 * q + 2] * (f32x2){u[2], u[2]}; bu1 += bb[4 * q + 3] * (f32x2){u[3], u[3]}; }
                sv = la * sv + lb * (f32x2){sv.y, sv.x} + (bu0 + bu1); } }
        E[(size_t)wu * 64 + lane] = sv;
        LDS_WAIT(); asm volatile("" ::: "memory");
    }
}
__device__ __forceinline__ float gelu_tanh(float y) { return 0.5f * y * (1.0f + tanhf(0.7978845608028654f * (y + 0.044715f * y * y * y))); }
typedef short bf16x8s __attribute__((ext_vector_type(8)));
constexpr int SSM_WLDS = 4096 + 16 * 288;
__device__ __forceinline__ void ssm_final_unit(const Args& a, unsigned char* ws, int l, int wu, LAS unsigned char* wlds, int lane) {
    const bf16_t* proj = (const bf16_t*)(ws + WS_PROJ); const f32x2* E = (const f32x2*)(ws + WS_SSME);
    float* YG = (float*)(ws + WS_YG); bf16_t* YGB = (bf16_t*)(ws + WS_YGB);
    LAS f32x4* ubuf = (LAS f32x4*)wlds; LAS unsigned char* sH = wlds + 4096;
    const int b = wu >> 11, g = (wu >> 6) & 31, ch = wu & 63, fr = lane & 15, q4 = lane >> 4;
    const size_t row0 = (size_t)b * SEQ + ch * 64;
    const bf16_t* up = proj + row0 * NINP + PC_SSM + g * 16;
    const u32x4 ub0 = *(const u32x4*)(up + (size_t)lane * NINP), ub1 = *(const u32x4*)(up + (size_t)lane * NINP + 8);
    float ar, ai, cr, ci; ssm_lambda(a, l, g, lane, ar, ai, cr, ci);
    f32x2 bb[16];
    { const f32x4* br = (const f32x4*)(a.in[I_BRE] + ((size_t)(l * 32 + g) * 64 + lane) * 16); const f32x4* bi = (const f32x4*)(a.in[I_BIM] + ((size_t)(l * 32 + g) * 64 + lane) * 16);
#pragma unroll
      for (int q = 0; q < 4; ++q) { const f32x4 x = br[q], y = bi[q];
#pragma unroll
          for (int e = 0; e < 4; ++e) bb[4 * q + e] = (f32x2){cr * x[e] - ci * y[e], cr * y[e] + ci * x[e]}; } }
    bf16x8s Ah[4], Al[4];
    { const float* cre = a.in[I_CRE] + ((size_t)(l * 32 + g) * 16 + fr) * 64 + 4 * q4; const float* cim = a.in[I_CIM] + ((size_t)(l * 32 + g) * 16 + fr) * 64 + 4 * q4;
#pragma unroll
      for (int ks = 0; ks < 4; ++ks) { const f32x4 xr = *(const f32x4*)(cre + 16 * ks), xi = *(const f32x4*)(cim + 16 * ks);
          const float v[8] = {xr[0], -xi[0], xr[1], -xi[1], xr[2], -xi[2], xr[3], -xi[3]}; u32x4 wh, wl; unsigned hh[4], ll[4];
#pragma unroll
          for (int i = 0; i < 4; ++i) { hh[i] = pk2(v[2 * i], v[2 * i + 1]); ll[i] = pk2(v[2 * i] - bf_lo(hh[i]), v[2 * i + 1] - bf_hi(hh[i])); }
          wh.x = hh[0]; wh.y = hh[1]; wh.z = hh[2]; wh.w = hh[3]; wl.x = ll[0]; wl.y = ll[1]; wl.z = ll[2]; wl.w = ll[3];
          Ah[ks] = __builtin_bit_cast(bf16x8s, wh); Al[ks] = __builtin_bit_cast(bf16x8s, wl); } }
    { float t0[8], t1[8]; bf8_to_f32(ub0, t0); bf8_to_f32(ub1, t1);
      ubuf[lane * 4 + 0] = (f32x4){t0[0], t0[1], t0[2], t0[3]}; ubuf[lane * 4 + 1] = (f32x4){t0[4], t0[5], t0[6], t0[7]}; ubuf[lane * 4 + 2] = (f32x4){t1[0], t1[1], t1[2], t1[3]}; ubuf[lane * 4 + 3] = (f32x4){t1[4], t1[5], t1[6], t1[7]}; }
    float pr = ar, pi = ai;
#pragma unroll
    for (int q = 0; q < 6; ++q) { const float nr = pr * pr - pi * pi, ni = 2.f * pr * pi; pr = nr; pi = ni; }
    float sr = 0.f, si = 0.f;
    { const f32x2* e = E + (size_t)(wu - ch) * 64 + lane;
      for (int m0 = 0; m0 < ch; m0 += 16) { f32x2 ev[16];
#pragma unroll
          for (int i = 0; i < 16; ++i) { const int mm = m0 + i < ch ? m0 + i : ch - 1; ev[i] = e[(size_t)mm * 64]; }
#pragma unroll
          for (int i = 0; i < 16; ++i) if (m0 + i < ch) { const float nr = pr * sr - pi * si + ev[i].x, ni = pr * si + pi * sr + ev[i].y; sr = nr; si = ni; } } }
    const f32x4 dsk = *(const f32x4*)(a.in[I_SD] + l * 512 + g * 16 + 4 * q4);
    f32x2 sv = {sr, si}; const f32x2 la = {ar, ar}, lb = {-ai, ai};
    LDS_WAIT(); asm volatile("" ::: "memory");
    for (int tile = 0; tile < 4; ++tile) {
#pragma unroll
        for (int hg = 0; hg < 2; ++hg) { f32x4 ug[8][4];
#pragma unroll
            for (int tt = 0; tt < 8; ++tt)
#pragma unroll
                for (int q = 0; q < 4; ++q) ug[tt][q] = ubuf[(tile * 16 + hg * 8 + tt) * 4 + q];
            __builtin_amdgcn_sched_barrier(0);
#pragma unroll
            for (int tt = 0; tt < 8; ++tt) { f32x2 bu0 = {0.f, 0.f}, bu1 = {0.f, 0.f};
#pragma unroll
                for (int q = 0; q < 4; ++q) { const f32x4 u = ug[tt][q];
                    bu0 += bb[4 * q + 0] * (f32x2){u[0], u[0]}; bu1 += bb[4 * q + 1] * (f32x2){u[1], u[1]}; bu0 += bb[4 * q + 2] * (f32x2){u[2], u[2]}; bu1 += bb[4 * q + 3] * (f32x2){u[3], u[3]}; }
                sv = la * sv + lb * (f32x2){sv.y, sv.x} + (bu0 + bu1);
                *(LAS unsigned*)(sH + (hg * 8 + tt) * 288 + lane * 4) = pk2(sv.x, sv.y); } }
        LDS_WAIT(); asm volatile("" ::: "memory");
        bf16x8s Bh[4];
#pragma unroll
        for (int ks = 0; ks < 4; ++ks) Bh[ks] = *(const LAS bf16x8s*)(sH + fr * 288 + ks * 64 + q4 * 16);
        const f32x4 u4 = ubuf[(tile * 16 + fr) * 4 + q4];
        f32x4 acc = zero_acc(), acc2 = zero_acc();
#pragma unroll
        for (int ks = 0; ks < 4; ++ks) { acc = __builtin_amdgcn_mfma_f32_16x16x32_bf16(Ah[ks], Bh[ks], acc, 0, 0, 0); acc2 = __builtin_amdgcn_mfma_f32_16x16x32_bf16(Al[ks], Bh[ks], acc2, 0, 0, 0); }
        acc = acc + acc2;
        f32x4 vo;
#pragma unroll
        for (int r = 0; r < 4; ++r) { const float yv = acc[r] + dsk[r] * u4[r];
            const float zz = 0.7978845608028654f * (yv + 0.044715f * yv * yv * yv), th = 1.0f - 2.0f * __builtin_amdgcn_rcpf(__expf(2.0f * zz) + 1.0f); vo[r] = 0.5f * yv * (1.0f + th); }
        const size_t oidx = (row0 + tile * 16 + fr) * 512 + g * 16 + 4 * q4;
        *(f32x4*)(YG + oidx) = vo; u32x2 wb; wb.x = pk2(vo[0], vo[1]); wb.y = pk2(vo[2], vo[3]); *(u32x2*)(YGB + oidx) = wb;
        LDS_WAIT(); asm volatile("" ::: "memory");
    }
}

__device__ __forceinline__ void mix_phase(const Args& a, unsigned char* ws, int l, int blk, int G, int tid) {
    const int lane = tid & 63, wave = __builtin_amdgcn_readfirstlane(tid >> 6), gw = blk * NWAVES + wave, ngw = G * NWAVES;
    const bf16_t* proj = (const bf16_t*)(ws + WS_PROJ); const float* YG = (const float*)(ws + WS_YG); const float* Z = (const float*)(ws + WS_Z);
    const float* DO = (const float*)(ws + WS_DO); const bf16_t* AO = (const bf16_t*)(ws + WS_AO); const float* ALSE = (const float*)(ws + WS_ALSE);
    bf16_t* MIX = (bf16_t*)(ws + WS_MIX);
    const float* glub = a.in[I_GLUB] + l * 512; const float* sg = a.in[I_SGAIN] + l * 512; const float* dng = a.in[I_DNG] + l * 128; const float* atg = a.in[I_ATG] + l * 768;
    for (int m = gw; m < M; m += ngw) {
        const f32x4* yp = (const f32x4*)(YG + (size_t)m * 512 + 8 * lane); const f32x4* zp = (const f32x4*)(Z + (size_t)m * 512 + 8 * lane);
        const f32x4 y0 = yp[0], y1 = yp[1], z0 = zp[0], z1 = zp[1];
        f32x2 od[6]; unsigned zw[6], aw[6][3]; float ls[6][3];
#pragma unroll
        for (int h = 0; h < 6; ++h) { od[h] = *(const f32x2*)(DO + (size_t)m * 768 + h * 128 + 2 * lane); zw[h] = *(const unsigned*)(proj + (size_t)m * NINP + PC_DZ + h * 128 + 2 * lane);
#pragma unroll
            for (int g3 = 0; g3 < 3; ++g3) { ls[h][g3] = ALSE[((size_t)g3 * M + m) * 8 + h]; aw[h][g3] = *(const unsigned*)(AO + ((size_t)g3 * M + m) * 768 + h * 128 + 2 * lane); } }
        const f32x4* bp = (const f32x4*)(glub + 8 * lane); const f32x4 b0 = bp[0], b1 = bp[1];
        float red[8];
        float v[8];
#pragma unroll
        for (int e = 0; e < 4; ++e) { v[e] = y0[e] * sigmoidf_(z0[e] + b0[e]); v[4 + e] = y1[e] * sigmoidf_(z1[e] + b1[e]); }
        red[0] = 0.f;
#pragma unroll
        for (int e = 0; e < 8; ++e) red[0] += v[e] * v[e];
#pragma unroll
        for (int h = 0; h < 6; ++h) red[1 + h] = od[h].x * od[h].x + od[h].y * od[h].y;
        float oa[6][2]; red[7] = 0.f;
#pragma unroll
        for (int h = 0; h < 6; ++h) { const float mx = fmaxf(ls[h][0], fmaxf(ls[h][1], ls[h][2])); const float w0 = __expf(ls[h][0] - mx), w1 = __expf(ls[h][1] - mx), w2 = __expf(ls[h][2] - mx), inv = 1.f / (w0 + w1 + w2);
            oa[h][0] = (w0 * bf_lo(aw[h][0]) + w1 * bf_lo(aw[h][1]) + w2 * bf_lo(aw[h][2])) * inv; oa[h][1] = (w0 * bf_hi(aw[h][0]) + w1 * bf_hi(aw[h][1]) + w2 * bf_hi(aw[h][2])) * inv;
            red[7] += oa[h][0] * oa[h][0] + oa[h][1] * oa[h][1]; }
#pragma unroll
        for (int o = 1; o < 64; o <<= 1) {
#pragma unroll
            for (int i = 0; i < 8; ++i) red[i] += shx(lane, red[i], o); }
        { const float r = rsqrtf(red[0] * (1.f / 512.f) + EPS); const f32x4* gp = (const f32x4*)(sg + 8 * lane); const f32x4 g0 = gp[0], g1 = gp[1];
          u32x4 w; w.x = pk2(v[0] * r * g0.x, v[1] * r * g0.y); w.y = pk2(v[2] * r * g0.z, v[3] * r * g0.w); w.z = pk2(v[4] * r * g1.x, v[5] * r * g1.y); w.w = pk2(v[6] * r * g1.z, v[7] * r * g1.w);
          *(u32x4*)(MIX + (size_t)m * D + 8 * lane) = w; }
        { const f32x2 g = *(const f32x2*)(dng + 2 * lane);
#pragma unroll
          for (int h = 0; h < 6; ++h) { const float r = rsqrtf(red[1 + h] * (1.f / 128.f) + EPS);
              *(unsigned*)(MIX + (size_t)m * D + 512 + h * 128 + 2 * lane) = pk2(od[h].x * r * g.x * siluf_(bf_lo(zw[h])), od[h].y * r * g.y * siluf_(bf_hi(zw[h]))); } }
        { const float r = rsqrtf(red[7] * (1.f / 768.f) + EPS);
#pragma unroll
          for (int h = 0; h < 6; ++h) { const f32x2 g = *(const f32x2*)(atg + h * 128 + 2 * lane);
              *(unsigned*)(MIX + (size_t)m * D + 1280 + h * 128 + 2 * lane) = pk2(oa[h][0] * r * g.x, oa[h][1] * r * g.y); } }
    }
}

constexpr int RS_LDS_OFF = 131072;
template <class Sched> __device__ __forceinline__ int load_row_scales(const Sched& S, const float* RS, LAS unsigned char* lds, int tid) {
    pg8::Unit u; (void)S.next(0, u);
    const int pm0 = (u.pm >> 3) << 3; ((LAS f32x4*)(lds + RS_LDS_OFF))[tid] = ((const f32x4*)(RS + (size_t)pm0 * 256))[tid];
    __syncthreads();
    return pm0;
}
typedef pg8::StaticOrder GemmOrder;
typedef short bf16x8 __attribute__((ext_vector_type(8)));
__device__ __forceinline__ int kperm(int k) { return (k & ~31) + 8 * ((k & 15) >> 2) + 4 * ((k >> 4) & 1) + (k & 3); }
__device__ __forceinline__ bf16x8 pack8(const f32x4 a, const f32x4 b) { u32x4 w; w.x = pk2(a[0], a[1]); w.y = pk2(a[2], a[3]); w.z = pk2(b[0], b[1]); w.w = pk2(b[2], b[3]); return __builtin_bit_cast(bf16x8, w); }
constexpr int DP_KS = 0, DP_VS = 33024, DP_QS = 66048, DP_KB = 99072, DP_QB = 117504, DP_MISC = 135936, DP_ATL = 137216, DP_AP = 68;
template <int C, int E0> __device__ __forceinline__ void dn_solve_batch(const LAS float* Amv, const float (&x)[64], float& s0, float& s1, float& s2, float& s3) {
    constexpr int NP = (C + 3) / 4, NB = (NP - E0) < 8 ? (NP - E0) : 8;
    if constexpr (NB > 0) { f32x4 av[NB];
#pragma unroll
        for (int i = 0; i < NB; ++i) av[i] = *(const LAS f32x4*)(Amv + C * DP_AP + 4 * (E0 + i));
        __builtin_amdgcn_sched_barrier(0);
#pragma unroll
        for (int i = 0; i < NB; ++i) { constexpr int dummy = 0; (void)dummy; const int e4 = E0 + i;
            if (4 * e4 + 0 < C) s0 -= av[i][0] * x[4 * e4 + 0]; if (4 * e4 + 1 < C) s1 -= av[i][1] * x[4 * e4 + 1];
            if (4 * e4 + 2 < C) s2 -= av[i][2] * x[4 * e4 + 2]; if (4 * e4 + 3 < C) s3 -= av[i][3] * x[4 * e4 + 3]; }
        __builtin_amdgcn_sched_barrier(0); }
}
template <int C> __device__ __forceinline__ void dn_solve_rows(const LAS float* Amv, float (&x)[64]) {
    if constexpr (C < 64) { float s0 = x[C], s1 = 0.f, s2 = 0.f, s3 = 0.f;
        dn_solve_batch<C, 0>(Amv, x, s0, s1, s2, s3); dn_solve_batch<C, 8>(Amv, x, s0, s1, s2, s3);
        x[C] = (s0 + s1) + (s2 + s3);
        dn_solve_rows<C + 1>(Amv, x); }
}
__device__ __forceinline__ void dn_chunk_prep(const Args& a, unsigned char* ws, int l, int unit, LAS unsigned char* lds, int tid_in) {
    int tid = tid_in; asm volatile("" : "+v"(tid));
    const int lane = tid & 63, wave = __builtin_amdgcn_readfirstlane(tid >> 6), q4 = lane >> 4, fr = lane & 15;
    const bf16_t* proj = (const bf16_t*)(ws + WS_PROJ);
    const int bh = unit >> 6, n = unit & 63, b = bh / 6, h = bh % 6, t0 = n * 64; const size_t row0 = (size_t)b * SEQ + t0;
    LAS float* ks = (LAS float*)(lds + DP_KS); LAS float* vs = (LAS float*)(lds + DP_VS); LAS float* qs = (LAS float*)(lds + DP_QS);
    LAS unsigned char* kb = lds + DP_KB; LAS unsigned char* qb = lds + DP_QB; LAS float* gcs = (LAS float*)(lds + DP_MISC); LAS float* bes = gcs + 64; LAS float* egs = gcs + 128; LAS float* eks = gcs + 192;
    bf16_t* WN = (bf16_t*)(ws + WS_DWN) + (size_t)unit * 8192; bf16_t* QD = (bf16_t*)(ws + WS_DQD) + (size_t)unit * 8192; bf16_t* KT = (bf16_t*)(ws + WS_DKT) + (size_t)unit * 8192;
    bf16_t* AT = (bf16_t*)(ws + WS_DAT) + (size_t)unit * 4096; float* UD = (float*)(ws + WS_DUD) + (size_t)unit * 8192; float* CD = (float*)(ws + WS_DCD);
    const float* cw = a.in[I_CONVW] + (size_t)l * 4 * 2304;
    __syncthreads();
    { const int d2 = tid & 63, c0 = 8 * (tid >> 6); unsigned xin[3][11]; float wv[3][4][2];
#pragma unroll
      for (int w3 = 0; w3 < 3; ++w3) { const int chn = w3 * 768 + h * 128 + 2 * d2;
#pragma unroll
          for (int i = 0; i < 4; ++i) { const f32x2 w2 = *(const f32x2*)(cw + i * 2304 + chn); wv[w3][i][0] = w2.x; wv[w3][i][1] = w2.y; }
#pragma unroll
          for (int i = 0; i < 11; ++i) xin[w3][i] = (t0 + c0 - 3 + i >= 0) ? *(const unsigned*)(proj + (row0 + c0 - 3 + i) * NINP + PC_DQKV + chn) : 0u; }
#pragma unroll
      for (int w3 = 0; w3 < 3; ++w3) { LAS float* dst = w3 == 0 ? qs : (w3 == 1 ? ks : vs);
#pragma unroll
          for (int c = 0; c < 8; ++c) {
              const float a0 = wv[w3][0][0] * bf_lo(xin[w3][c]) + wv[w3][1][0] * bf_lo(xin[w3][c + 1]) + wv[w3][2][0] * bf_lo(xin[w3][c + 2]) + wv[w3][3][0] * bf_lo(xin[w3][c + 3]);
              const float a1 = wv[w3][0][1] * bf_hi(xin[w3][c]) + wv[w3][1][1] * bf_hi(xin[w3][c + 1]) + wv[w3][2][1] * bf_hi(xin[w3][c + 2]) + wv[w3][3][1] * bf_hi(xin[w3][c + 3]);
              dst[(c0 + c) * 129 + 2 * d2] = a0 * __builtin_amdgcn_rcpf(1.0f + __builtin_amdgcn_exp2f(-1.44269504089f * a0));
              dst[(c0 + c) * 129 + 2 * d2 + 1] = a1 * __builtin_amdgcn_rcpf(1.0f + __builtin_amdgcn_exp2f(-1.44269504089f * a1)); } } }
    if (wave == 0) { const size_t row = row0 + lane; const float av = __uint_as_float((unsigned)proj[row * NINP + PC_DA + h] << 16), bv = __uint_as_float((unsigned)proj[row * NINP + PC_DB + h] << 16);
        const float x = av + a.in[I_DTB][l * 6 + h]; const float sp = fmaxf(x, 0.f) + log1pf(expf(-fabsf(x))); float g = -expf(a.in[I_ALOG][l * 6 + h]) * sp;
#pragma unroll
        for (int o = 1; o < 64; o <<= 1) { const float t = __int_as_float(__builtin_amdgcn_ds_bpermute(((lane - o) & 63) << 2, __float_as_int(g))); if (lane >= o) g += t; }
        const float glast = __int_as_float(__builtin_amdgcn_readlane(__float_as_int(g), 63));
        gcs[lane] = g; bes[lane] = sigmoidf_(bv); egs[lane] = expf(g); eks[lane] = expf(glast - g); if (lane == 63) CD[unit] = expf(g); }
    __syncthreads();
    { const int c = wave * 8 + (lane >> 3), sg = lane & 7; float qv[16], kv[16]; float sq = 0.f, sk = 0.f;
#pragma unroll
      for (int i = 0; i < 16; ++i) { qv[i] = qs[c * 129 + 16 * sg + i]; kv[i] = ks[c * 129 + 16 * sg + i]; sq += qv[i] * qv[i]; sk += kv[i] * kv[i]; }
#pragma unroll
      for (int o = 1; o < 8; o <<= 1) { sq += shx(lane, sq, o); sk += shx(lane, sk, o); }
      const float qsc = rsqrtf(sq + EPS) * 0.08838834764831845f, ksc = rsqrtf(sk + EPS);
#pragma unroll
      for (int i = 0; i < 16; ++i) { qv[i] *= qsc; kv[i] *= ksc; qs[c * 129 + 16 * sg + i] = qv[i]; ks[c * 129 + 16 * sg + i] = kv[i]; }
      u32x4 w0, w1; w0.x = pk2(qv[0], qv[1]); w0.y = pk2(qv[2], qv[3]); w0.z = pk2(qv[4], qv[5]); w0.w = pk2(qv[6], qv[7]); w1.x = pk2(qv[8], qv[9]); w1.y = pk2(qv[10], qv[11]); w1.z = pk2(qv[12], qv[13]); w1.w = pk2(qv[14], qv[15]);
      *(LAS u32x4*)(qb + c * 288 + sg * 32) = w0; *(LAS u32x4*)(qb + c * 288 + sg * 32 + 16) = w1;
      w0.x = pk2(kv[0], kv[1]); w0.y = pk2(kv[2], kv[3]); w0.z = pk2(kv[4], kv[5]); w0.w = pk2(kv[6], kv[7]); w1.x = pk2(kv[8], kv[9]); w1.y = pk2(kv[10], kv[11]); w1.z = pk2(kv[12], kv[13]); w1.w = pk2(kv[14], kv[15]);
      *(LAS u32x4*)(kb + c * 288 + sg * 32) = w0; *(LAS u32x4*)(kb + c * 288 + sg * 32 + 16) = w1; }
    __syncthreads();
#pragma unroll
    for (int i = 0; i < 2; ++i) { const int pi = tid + NTHR * i, c = pi >> 4, pc = pi & 15, s0 = (pc >> 2) * 32 + 4 * (pc & 3); float v[8];
#pragma unroll
        for (int j = 0; j < 4; ++j) { v[j] = qs[c * 129 + s0 + j]; v[4 + j] = qs[c * 129 + s0 + 16 + j]; }
        const float sc = egs[c]; u32x4 w; w.x = pk2(v[0] * sc, v[1] * sc); w.y = pk2(v[2] * sc, v[3] * sc); w.z = pk2(v[4] * sc, v[5] * sc); w.w = pk2(v[6] * sc, v[7] * sc);
        *(u32x4*)(QD + c * 128 + pc * 8) = w; }
#pragma unroll
    for (int i = 0; i < 2; ++i) { const int pi = tid + NTHR * i, dk = pi >> 3, pc = pi & 7, c0 = (pc >> 2) * 32 + 4 * (pc & 3); float v[8], e[8];
#pragma unroll
        for (int j = 0; j < 4; ++j) { v[j] = ks[(c0 + j) * 129 + dk]; v[4 + j] = ks[(c0 + 16 + j) * 129 + dk]; e[j] = eks[c0 + j]; e[4 + j] = eks[c0 + 16 + j]; }
        u32x4 w; w.x = pk2(v[0] * e[0], v[1] * e[1]); w.y = pk2(v[2] * e[2], v[3] * e[3]); w.z = pk2(v[4] * e[4], v[5] * e[5]); w.w = pk2(v[6] * e[6], v[7] * e[7]);
        *(u32x4*)(KT + dk * 64 + pc * 8) = w; }
    __syncthreads();
    LAS float* Am = qs;
    for (int job = wave; job < 32; job += NWAVES) { const int kind = job >> 4, ti = (job >> 2) & 3, tj = job & 3;
        f32x4 acc = zero_acc();
        if (ti >= tj) { const LAS unsigned char* ab = (kind ? qb : kb) + (16 * ti + fr) * 288 + q4 * 16; const LAS unsigned char* bb = kb + (16 * tj + fr) * 288 + q4 * 16;
#pragma unroll
            for (int k4 = 0; k4 < 4; ++k4) acc = __builtin_amdgcn_mfma_f32_16x16x32_bf16(*(const LAS bf16x8*)(ab + k4 * 64), *(const LAS bf16x8*)(bb + k4 * 64), acc, 0, 0, 0); }
        const int e = 16 * tj + fr; const float ge = gcs[e];
#pragma unroll
        for (int r = 0; r < 4; ++r) { const int c = 16 * ti + 4 * q4 + r; const float dec = expf(fminf(gcs[c] - ge, 0.f));
            if (kind == 0) { Am[c * DP_AP + e] = (c > e) ? bes[c] * acc[r] * dec : 0.f; }
            else { *(LAS bf16_t*)(lds + DP_ATL + c * 144 + kperm(e) * 2) = (bf16_t)(pk2((c >= e) ? acc[r] * dec : 0.f, 0.f) & 0xffffu); } } }
    __syncthreads();
    { const int c = tid >> 3, pc = tid & 7; *(u32x4*)(AT + c * 64 + pc * 8) = *(const LAS u32x4*)(lds + DP_ATL + c * 144 + pc * 16); }
    if (tid < 256) { const int col = tid & 127; const bool isw = tid >= 128; float x[64]; int zoff = 0; asm volatile("" : "+v"(zoff));
        const LAS float* Amv = Am + zoff;
        { const LAS float* src = (isw ? ks : vs) + col; const LAS f32x4* b4p = (const LAS f32x4*)(bes + zoff); const LAS f32x4* e4p = (const LAS f32x4*)(egs + zoff);
#pragma unroll
          for (int c = 0; c < 64; ++c) x[c] = src[c * 129];
#pragma unroll
          for (int g4 = 0; g4 < 4; ++g4) { f32x4 b4[4], e4[4];
#pragma unroll
              for (int i = 0; i < 4; ++i) { b4[i] = b4p[4 * g4 + i]; e4[i] = e4p[4 * g4 + i]; }
#pragma unroll
              for (int c = 0; c < 16; ++c) x[16 * g4 + c] = x[16 * g4 + c] * b4[c >> 2][c & 3] * (isw ? e4[c >> 2][c & 3] : 1.0f); } }
        dn_solve_rows<1>(Amv, x);
        if (!isw) { const int s8 = col >> 4, f = col & 15;
#pragma unroll
            for (int mt = 0; mt < 4; ++mt)
#pragma unroll
                for (int qq = 0; qq < 4; ++qq) *(f32x4*)(UD + ((size_t)((s8 * 4 + mt) * 64 + qq * 16 + f)) * 4) = (f32x4){x[16 * mt + 4 * qq], x[16 * mt + 4 * qq + 1], x[16 * mt + 4 * qq + 2], x[16 * mt + 4 * qq + 3]}; }
        else { const int p = kperm(col);
#pragma unroll
            for (int c = 0; c < 64; ++c) *(LAS bf16_t*)(kb + c * 288 + p * 2) = (bf16_t)(pk2(-x[c], 0.f) & 0xffffu); } }
    __syncthreads();
#pragma unroll
    for (int i = 0; i < 2; ++i) { const int pi = tid + NTHR * i, c = pi >> 4, pc = pi & 15; *(u32x4*)(WN + c * 128 + pc * 8) = *(const LAS u32x4*)(kb + c * 288 + pc * 16); }
}
constexpr int DS2_WN = 0, DS2_KT = 18432, DS2_BYTES = 38912;
__device__ __forceinline__ void dn_scan_wg2(unsigned char* ws, int bh, int half, LAS unsigned char* lds, int tid) {
    const int lane = tid & 63, wv = __builtin_amdgcn_readfirstlane(tid >> 6), s8 = half * 4 + (wv & 3), q4 = lane >> 4, fr = lane & 15; const bool cw = wv < 4;
    const f32x4 z4 = {0.f, 0.f, 0.f, 0.f};
    f32x4 S[8]; bf16x8 Sb[4];
#pragma unroll
    for (int i = 0; i < 8; ++i) S[i] = z4;
#pragma unroll
    for (int i = 0; i < 4; ++i) Sb[i] = pack8(z4, z4);
    const int r16a = tid >> 4, pc16 = tid & 15, r8a = tid >> 3, pc8 = tid & 7;
    const unsigned char* gWN = ws + WS_DWN + (size_t)bh * 64 * 16384; const unsigned char* gKT = ws + WS_DKT + (size_t)bh * 64 * 16384;
    const f32x4* gUD = (const f32x4*)(ws + WS_DUD) + ((size_t)bh * 64 * 8 + s8) * 256 + lane;
    bf16x8* gSS = (bf16x8*)(ws + WS_DSS) + ((size_t)bh * 64 * 8 + s8) * 256 + lane; bf16x8* gVN = (bf16x8*)(ws + WS_DVN) + ((size_t)bh * 64 * 8 + s8) * 128 + lane;
    u32x4 st[4]; f32x4 udn[4]; float decn;
    const float* gCD = (const float*)(ws + WS_DCD) + bh * 64;
#define DN_LOAD2(n_) do { const size_t o16 = (size_t)(n_) * 16384; \
        st[0] = *(const u32x4*)(gWN + o16 + r16a * 256 + pc16 * 16); st[1] = *(const u32x4*)(gWN + o16 + (r16a + 32) * 256 + pc16 * 16); \
        st[2] = *(const u32x4*)(gKT + o16 + r8a * 128 + pc8 * 16); st[3] = *(const u32x4*)(gKT + o16 + (r8a + 64) * 128 + pc8 * 16); \
        decn = gCD[n_]; \
        if (cw) { _Pragma("unroll") for (int mt = 0; mt < 4; ++mt) udn[mt] = gUD[(size_t)(n_) * 2048 + mt * 64]; } } while (0)
    DN_LOAD2(0);
    const LAS unsigned char* aW = lds + DS2_WN + fr * 288 + q4 * 16; const LAS unsigned char* aK = lds + DS2_KT + fr * 160 + q4 * 16;
    for (int n = 0; n < 64; ++n) {
        __syncthreads();
        *(LAS u32x4*)(lds + DS2_WN + r16a * 288 + pc16 * 16) = st[0]; *(LAS u32x4*)(lds + DS2_WN + (r16a + 32) * 288 + pc16 * 16) = st[1];
        *(LAS u32x4*)(lds + DS2_KT + r8a * 160 + pc8 * 16) = st[2]; *(LAS u32x4*)(lds + DS2_KT + (r8a + 64) * 160 + pc8 * 16) = st[3];
        f32x4 vn[4];
#pragma unroll
        for (int mt = 0; mt < 4; ++mt) vn[mt] = udn[mt];
        const float dec = decn;
        if (cw) {
#pragma unroll
        for (int i = 0; i < 4; ++i) gSS[(size_t)n * 2048 + i * 64] = Sb[i]; }
        { const int nn = n + 1 < 64 ? n + 1 : 63; DN_LOAD2(nn); }
        __syncthreads();
        if (cw) {
        bf16x8 fw[16], fk[16];
#pragma unroll
        for (int i = 0; i < 16; ++i) fw[i] = *(const LAS bf16x8*)(aW + (i >> 2) * 16 * 288 + (i & 3) * 64);
        __builtin_amdgcn_sched_barrier(0);
#pragma unroll
        for (int k4 = 0; k4 < 4; ++k4)
#pragma unroll
            for (int mt = 0; mt < 4; ++mt) vn[mt] = __builtin_amdgcn_mfma_f32_16x16x32_bf16(fw[mt * 4 + k4], Sb[k4], vn[mt], 0, 0, 0);
        __builtin_amdgcn_sched_barrier(0);
#pragma unroll
        for (int i = 0; i < 16; ++i) fk[i] = *(const LAS bf16x8*)(aK + (i >> 1) * 16 * 160 + (i & 1) * 64);
#pragma unroll
        for (int t8 = 0; t8 < 8; ++t8) S[t8] = S[t8] * dec;
        bf16x8 Vb[2]; Vb[0] = pack8(vn[0], vn[1]); Vb[1] = pack8(vn[2], vn[3]);
        gVN[(size_t)n * 1024] = Vb[0]; gVN[(size_t)n * 1024 + 64] = Vb[1];
        __builtin_amdgcn_sched_barrier(0);
#pragma unroll
        for (int k2 = 0; k2 < 2; ++k2)
#pragma unroll
            for (int t8 = 0; t8 < 8; ++t8) S[t8] = __builtin_amdgcn_mfma_f32_16x16x32_bf16(fk[t8 * 2 + k2], Vb[k2], S[t8], 0, 0, 0);
#pragma unroll
        for (int i = 0; i < 4; ++i) Sb[i] = pack8(S[2 * i], S[2 * i + 1]);
        }
    }
#undef DN_LOAD2
    __syncthreads();
}
__device__ __forceinline__ void dn_out_unit(unsigned char* ws, int unit, int tid) {
    const int lane = tid & 63, s8 = __builtin_amdgcn_readfirstlane(tid >> 6), q4 = lane >> 4, fr = lane & 15;
    const int bh = unit >> 6, n = unit & 63, b = bh / 6, h = bh % 6;
    const bf16_t* qd = (const bf16_t*)(ws + WS_DQD) + (size_t)unit * 8192 + fr * 128 + q4 * 8; const bf16_t* at = (const bf16_t*)(ws + WS_DAT) + (size_t)unit * 4096 + fr * 64 + q4 * 8;
    const bf16x8* gSS = (const bf16x8*)(ws + WS_DSS) + ((size_t)unit * 8 + s8) * 256 + lane; const bf16x8* gVN = (const bf16x8*)(ws + WS_DVN) + ((size_t)unit * 8 + s8) * 128 + lane;
    bf16x8 Sb[4], Vb[2], fq[16], fa[8];
#pragma unroll
    for (int i = 0; i < 4; ++i) Sb[i] = gSS[i * 64];
    Vb[0] = gVN[0]; Vb[1] = gVN[64];
#pragma unroll
    for (int i = 0; i < 16; ++i) fq[i] = *(const bf16x8*)(qd + (i >> 2) * 2048 + (i & 3) * 32);
#pragma unroll
    for (int i = 0; i < 8; ++i) fa[i] = *(const bf16x8*)(at + (i >> 1) * 1024 + (i & 1) * 32);
    __builtin_amdgcn_sched_barrier(0);
    f32x4 o[4]; float* DO = (float*)(ws + WS_DO);
#pragma unroll
    for (int mt = 0; mt < 4; ++mt) o[mt] = zero_acc();
#pragma unroll
    for (int k4 = 0; k4 < 4; ++k4)
#pragma unroll
        for (int mt = 0; mt < 4; ++mt) o[mt] = __builtin_amdgcn_mfma_f32_16x16x32_bf16(fq[mt * 4 + k4], Sb[k4], o[mt], 0, 0, 0);
#pragma unroll
    for (int k2 = 0; k2 < 2; ++k2)
#pragma unroll
        for (int mt = 0; mt < 4; ++mt) o[mt] = __builtin_amdgcn_mfma_f32_16x16x32_bf16(fa[mt * 2 + k2], Vb[k2], o[mt], 0, 0, 0);
#pragma unroll
    for (int mt = 0; mt < 4; ++mt) { float* orow = DO + ((size_t)b * SEQ + n * 64 + 16 * mt + 4 * q4) * 768 + h * 128 + 16 * s8 + fr;
#pragma unroll
        for (int r = 0; r < 4; ++r) orow[(size_t)r * 768] = o[mt][r]; }
}

typedef short s16x4 __attribute__((ext_vector_type(4)));
constexpr int A2_K = 0, A2_V = 73728, A2_BIAS = 147456, A2_P = 288;
__device__ __forceinline__ s16x4 tr_read(const LAS unsigned char* p) { return __builtin_bit_cast(s16x4, __builtin_amdgcn_ds_read_tr16_b64_v4i16((LAS s16x4*)p)); }
__device__ __forceinline__ void attn_unit_mfma(const Args& a, unsigned char* ws, int unit, LAS unsigned char* lds, int tid) {
    const int lane = tid & 63, w = __builtin_amdgcn_readfirstlane(tid >> 6), q4 = lane >> 4, fr = lane & 15;
    const bf16_t* proj = (const bf16_t*)(ws + WS_PROJ);
    const int gi = unit / 384, rem = unit % 384, b = rem / 192, h = (rem >> 5) % 6, idx = rem & 31;
    const int dl = gi == 0 ? 1 : (gi == 1 ? 4 : 16), r = idx % dl, qb = idx / dl, i0 = qb * 128;
    bf16_t* AO = (bf16_t*)(ws + WS_AO) + (size_t)gi * M * 768; float* ALSE = (float*)(ws + WS_ALSE) + (size_t)gi * M * 8;
    LAS unsigned char* Kl = lds + A2_K; LAS unsigned char* Vl = lds + A2_V; LAS float* biasT = (LAS float*)(lds + A2_BIAS);
    __syncthreads();
    { u32x4 kw[8], vw[8];
#pragma unroll
      for (int i = 0; i < 8; ++i) { const int it = tid + NTHR * i, kk = it >> 4, c8 = it & 15, j = i0 - 128 + kk; const int jj = j < 0 ? 0 : j;
          const size_t row = (size_t)b * SEQ + (size_t)jj * dl + r; kw[i] = *(const u32x4*)(proj + row * NINP + PC_AK + h * 128 + 8 * c8); vw[i] = *(const u32x4*)(proj + row * NINP + PC_AV + h * 128 + 8 * c8); }
#pragma unroll
      for (int i = 0; i < 8; ++i) { const int it = tid + NTHR * i, kk = it >> 4, c8 = it & 15;
          *(LAS u32x4*)(Kl + kk * A2_P + c8 * 16) = kw[i]; *(LAS u32x4*)(Vl + kk * A2_P + c8 * 16) = vw[i]; } }
    if (tid < 129) { const int dist = tid * dl; int bucket;
        if (dist < 16) bucket = dist; else { const float lg = 16.f + logf((float)dist / 16.f) / 4.852030263919617f * 16.f; bucket = (int)lg; bucket = bucket > 31 ? 31 : bucket; }
        biasT[tid] = a.in[I_RELB][bucket * 6 + h]; }
    const size_t qrow = (size_t)b * SEQ + (size_t)(i0 + 16 * w + fr) * dl + r;
    bf16x8 Qf[4];
    { const bf16_t* qp = proj + qrow * NINP + PC_AQ + h * 128 + 8 * q4;
#pragma unroll
      for (int ks = 0; ks < 4; ++ks) Qf[ks] = *(const bf16x8*)(qp + 32 * ks); }
    __syncthreads();
    f32x4 sc9[9]; float mx = -1e30f;
#pragma unroll
    for (int t = 0; t < 9; ++t) { f32x4 acc = zero_acc(); const LAS unsigned char* kr = Kl + (16 * (w + t) + fr) * A2_P + q4 * 16;
#pragma unroll
        for (int ks = 0; ks < 4; ++ks) acc = __builtin_amdgcn_mfma_f32_16x16x32_bf16(*(const LAS bf16x8*)(kr + ks * 64), Qf[ks], acc, 0, 0, 0);
#pragma unroll
        for (int e = 0; e < 4; ++e) { const int rel = 128 + fr - 16 * t - 4 * q4 - e, kl = 16 * (w + t) + 4 * q4 + e; const bool valid = (rel >= 0) && (rel <= 128) && (i0 - 128 + kl >= 0);
            const float s = valid ? acc[e] * 0.08838834764831845f + biasT[rel < 0 ? 0 : (rel > 128 ? 128 : rel)] : -1e30f; acc[e] = s; mx = fmaxf(mx, s); }
        sc9[t] = acc; }
    mx = fmaxf(mx, shx(lane, mx, 16)); mx = fmaxf(mx, shx(lane, mx, 32));
    float sum = 0.f;
#pragma unroll
    for (int t = 0; t < 9; ++t)
#pragma unroll
        for (int e = 0; e < 4; ++e) { const float p = __expf(sc9[t][e] - mx); sc9[t][e] = p; sum += p; }
    sum += shx(lane, sum, 16); sum += shx(lane, sum, 32);
    f32x4 o[8];
#pragma unroll
    for (int dt = 0; dt < 8; ++dt) o[dt] = zero_acc();
    const f32x4 z4 = {0.f, 0.f, 0.f, 0.f};
#pragma unroll
    for (int s = 0; s < 5; ++s) { const bf16x8 Pf = pack8(sc9[2 * s], s < 4 ? sc9[2 * s + 1] : z4);
        const LAS unsigned char* v0 = Vl + (16 * w + 32 * s + 4 * q4 + (fr >> 2)) * A2_P + 8 * (fr & 3); const LAS unsigned char* v1 = s < 4 ? v0 + 16 * A2_P : v0;
#pragma unroll
        for (int dt = 0; dt < 8; ++dt) { const s16x4 lo = tr_read(v0 + dt * 32), hi = tr_read(v1 + dt * 32);
            const bf16x8 Vf = {lo[0], lo[1], lo[2], lo[3], hi[0], hi[1], hi[2], hi[3]};
            o[dt] = __builtin_amdgcn_mfma_f32_16x16x32_bf16(Vf, Pf, o[dt], 0, 0, 0); } }
    const float inv = 1.f / sum;
    bf16_t* orow = AO + qrow * 768 + h * 128 + 4 * q4;
#pragma unroll
    for (int dt = 0; dt < 8; ++dt) { u32x2 w; w.x = pk2(o[dt][0] * inv, o[dt][1] * inv); w.y = pk2(o[dt][2] * inv, o[dt][3] * inv); *(u32x2*)(orow + 16 * dt) = w; }
    if (q4 == 0) ALSE[qrow * 8 + h] = mx + logf(sum);
}

constexpr int PH_PER_LAYER = 13, NPH = 1 + PH_PER_LAYER * DEPTH;
__global__ void __launch_bounds__(NTHR, 2) fwd_kernel(Args args) {
    extern __shared__ __attribute__((aligned(16))) unsigned char lds_raw[];
    LAS unsigned char* lds = (LAS unsigned char*)lds_raw;
    volatile LAS unsigned* MISC = (volatile LAS unsigned*)(lds + MISC_OFF);
    const int tid = threadIdx.x;
    const int G = gridDim.x, blk = blockIdx.x;
    const int lo = args.ph_lo, hi = args.ph_hi;
    unsigned char* ws = args.ws;
    if (tid < 64) MISC[tid] = 0u;
    __syncthreads();
    XcdBarrier bar; bar.bar = (unsigned*)(ws + WS_CTL) + CW_BAR; bar.x = 0; bar.st = nullptr;
    if (hi - lo > 1) bar = xcd_barrier_post((unsigned*)(ws + WS_CTL) + CW_BAR, MISC + 8);
#define PSITE(S_, k_) do {} while (0)
#define IN(k) (lo <= (k) && (k) < hi)
#define FRESH() int tidl = tid; unsigned wz_ = 0; int blkl = blk; asm volatile("" : "+v"(tidl), "+s"(wz_), "+s"(blkl)); unsigned char* wsl = ws + wz_
#define SEAM(k) do { if (IN(k) && IN((k) + 1)) xcd_barrier(bar); } while (0)

    if (IN(0)) { FRESH(); p0_prologue(args, wsl, lds, blk, G, tidl); }
    SEAM(0);
    for (int l = 0; l < DEPTH; ++l) {
        const int pb = 1 + PH_PER_LAYER * l;
        const float* gains = args.in[I_GAINS] + (size_t)l * 6 * D;
#pragma unroll
        for (int f = 0; f < 2; ++f) {
            const int p0 = pb + (f ? 10 : 0);
            if (IN(p0)) {
                FRESH(); pg8::Gemm g{(const bf16_t*)(wsl + WS_X), (const bf16_t*)(wsl + WS_WGU) + (size_t)(l * 2 + f) * NGU * D, M, NGU, D};
                GemmOrder S; S.init(M, NGU, G, blkl); PSITE(S, 1); const int pm0 = load_row_scales(S, (const float*)(wsl + WS_RS), lds, tidl);
                pg8::EpiSwiGLU E{(bf16_t*)(wsl + WS_ACT), DFF, (const LAS float*)(lds + RS_LDS_OFF), pm0};
                pg8::gemm_phase<pg8::EpiSwiGLU, GemmOrder, true, true>(lds, g, S, E, tidl);
                conv_slot(args, wsl, l + 1, l * 3 + f, (unsigned)G, lds, MISC, tidl);
            }
            SEAM(p0);
            if (IN(p0 + 1)) {
                FRESH(); pg8::Gemm g{(const bf16_t*)(wsl + WS_ACT), (const bf16_t*)(wsl + WS_WD) + (size_t)(l * 2 + f) * D * DFF, M, D, DFF}; GemmOrder S; S.init(M, D, G, blkl); PSITE(S, 2);
                pg8::EpiBf16P E{(bf16_t*)(wsl + WS_Y), D};
                pg8::gemm_phase<pg8::EpiBf16P, GemmOrder, true, true>(lds, g, S, E, tidl);
            }
            SEAM(p0 + 1);
            if (IN(p0 + 2)) {
                const bool last = (f == 1 && l == DEPTH - 1);
                if (f == 1) { FRESH(); conv_slot(args, wsl, l + 1, 15, 0u, lds, MISC, tidl); }
                FRESH(); bf16_t* X = (bf16_t*)(wsl + WS_X); const bf16_t* Yb = (const bf16_t*)(wsl + WS_Y); float* RS = (float*)(wsl + WS_RS);
                const float* gpost = gains + (f ? 5 : 1) * D;
                if (f == 0 && l == 0) thin_phase<true, false>(args.in[I_X], X, Yb, gpost, 0.5f, RS, blk, G, tidl);
                else if (last) thin_phase<false, true>(X, args.out, Yb, gpost, 0.5f, (float*)nullptr, blk, G, tidl);
                else thin_phase<false, false>(X, X, Yb, gpost, 0.5f, RS, blk, G, tidl);
            }
            SEAM(p0 + 2);
            if (f == 1) break;
            if (IN(pb + 3)) {
                FRESH(); pg8::Gemm g{(const bf16_t*)(wsl + WS_X), (const bf16_t*)(wsl + WS_WIN) + (size_t)l * NINP * D, M, NINP, D}; GemmOrder S; S.init(M, NINP, G, blkl); PSITE(S, 3); const int pm0 = load_row_scales(S, (const float*)(wsl + WS_RS), lds, tidl);
                pg8::EpiBf16PS E{(bf16_t*)(wsl + WS_PROJ), NINP, (const LAS float*)(lds + RS_LDS_OFF), pm0};
                pg8::gemm_phase<pg8::EpiBf16PS, GemmOrder, true, true>(lds, g, S, E, tidl);
            }
            SEAM(pb + 3);
            if (IN(pb + 4)) { FRESH();
                ssm_local(args, wsl, l, blk, G, tidl, lds);
                for (int u = blk; u < 768; u += G) dn_chunk_prep(args, wsl, l, u, lds, tidl); }
            SEAM(pb + 4);
            if (IN(pb + 5)) {
                FRESH(); const int lane = tidl & 63, wave = __builtin_amdgcn_readfirstlane(tidl >> 6), gw = blk * NWAVES + wave, ngw = G * NWAVES;
                if (blk < 24) { dn_scan_wg2(wsl, blk >> 1, blk & 1, lds, tidl); }
                if (blk >= 24) for (int wu = (blk - 24) * NWAVES + wave; wu < 4096; wu += (G - 24) * NWAVES) ssm_final_unit(args, wsl, l, wu, lds + wave * SSM_WLDS, lane);
                __syncthreads();
                if (blk >= 24) for (int u = blk - 24; u < 1152; u += G - 24) attn_unit_mfma(args, wsl, u, lds, tidl);
                conv_slot(args, wsl, l + 1, l * 3 + 2, (unsigned)G, lds, MISC, tidl);
            }
            SEAM(pb + 5);
            if (IN(pb + 6)) {
                if (blk >= 64) { FRESH(); for (int u = blk - 64; u < 768; u += G - 64) dn_out_unit(wsl, u, tidl); }
                FRESH(); pg8::Gemm g{(const bf16_t*)(wsl + WS_YGB), (const bf16_t*)(wsl + WS_WGLU) + (size_t)l * 512 * 512, M, 512, 512}; GemmOrder S; S.init(M, 512, G, blkl); PSITE(S, 4);
                pg8::EpiF32 E{(float*)(wsl + WS_Z), 512};
                pg8::gemm_phase<pg8::EpiF32, GemmOrder, true, true>(lds, g, S, E, tidl);
            }
            SEAM(pb + 6);
            if (IN(pb + 7)) { FRESH(); mix_phase(args, wsl, l, blk, G, tidl);
            }
            SEAM(pb + 7);
            if (IN(pb + 8)) {
                FRESH(); pg8::Gemm g{(const bf16_t*)(wsl + WS_MIX), (const bf16_t*)(wsl + WS_WOUT) + (size_t)l * D * D, M, D, D}; GemmOrder S; S.init(M, D, G, blkl); PSITE(S, 5);
                pg8::EpiBf16P E{(bf16_t*)(wsl + WS_Y), D};
                pg8::gemm_phase<pg8::EpiBf16P, GemmOrder, true, true>(lds, g, S, E, tidl);
            }
            SEAM(pb + 8);
            if (IN(pb + 9)) { FRESH(); bf16_t* X = (bf16_t*)(wsl + WS_X); thin_phase<false, false>(X, X, (const bf16_t*)(wsl + WS_Y), gains + 3 * D, 1.0f, (float*)(wsl + WS_RS), blk, G, tidl); }
            SEAM(pb + 9);
        }
    }
#undef IN
#undef SEAM
}

#ifndef MK_ONE_LAUNCH
#define MK_ONE_LAUNCH 1
#endif
extern "C" void kernel_launch(void* const* d_in, const int* in_sizes, int n_in, void* d_out, int out_size, void* d_ws, size_t ws_size, hipStream_t stream) {
    static int grid = 0;
    if (grid == 0) {
        if (n_in != N_IN || in_sizes[0] != M * D || out_size != M * D || ws_size < WS_END) { fprintf(stderr, "kernel_launch: unexpected shapes (n_in %d, in0 %d, out %d, ws %zu, need %zu)\n", n_in, n_in > 0 ? in_sizes[0] : -1, out_size, ws_size, (size_t)WS_END); grid = -1; return; }
        int dev = 0, cus = 0, per_cu = 0;
        if (hipGetDevice(&dev) != hipSuccess || hipDeviceGetAttribute(&cus, hipDeviceAttributeMultiprocessorCount, dev) != hipSuccess) { grid = -1; return; }
        if (hipFuncSetAttribute((const void*)fwd_kernel, hipFuncAttributeMaxDynamicSharedMemorySize, LDS_BYTES) != hipSuccess) { fprintf(stderr, "kernel_launch: hipFuncSetAttribute failed\n"); grid = -1; return; }
        if (hipOccupancyMaxActiveBlocksPerMultiprocessor(&per_cu, (const void*)fwd_kernel, NTHR, LDS_BYTES) != hipSuccess || per_cu < 1) fprintf(stderr, "kernel_launch: occupancy query reports %d\n", per_cu);
        (void)hipGetLastError();
        if (cus != 256) { fprintf(stderr, "kernel_launch: built for a 256-CU device (got %d)\n", cus); grid = -1; return; }
        grid = cus;
    }
    if (grid < 0) return;
    (void)hipMemsetAsync((char*)d_ws + WS_CTL, 0, CTL_ZERO_BYTES, stream);
    Args a{};
    for (int i = 0; i < N_IN; ++i) a.in[i] = (const float*)d_in[i];
    a.out = (float*)d_out; a.ws = (unsigned char*)d_ws;
#if MK_ONE_LAUNCH
    a.ph_lo = 0; a.ph_hi = NPH;
    hipLaunchKernelGGL(fwd_kernel, dim3(grid), dim3(NTHR), LDS_BYTES, stream, a);
#else
    for (int p = 0; p < NPH; ++p) { a.ph_lo = p; a.ph_hi = p + 1; hipLaunchKernelGGL(fwd_kernel, dim3(grid), dim3(NTHR), LDS_BYTES, stream, a); }
#endif
}
```
